# Optimizing an MI355X kernel written in HIP

```python
import jax, jax.numpy as jnp
from jax import lax
import numpy as np

D_MODEL = 1024
BATCH = 16
SEQ = 2048
DEPTH = 1
DEC_BATCH = 128
DEC_SEQ = 1
PAST_LEN = 16384
PAGE_SIZE = 128

HEAD_DIM = 64
N_HEADS_A = 16
N_KV_A = 2
GROUP_A = N_HEADS_A // N_KV_A
WINDOW_A = 128
DILATED_PAIRS = ((128, 1), (512, 4), (2048, 16))
N_GROUPS_B = 3
HEADS_PER_GROUP_B = 4
SPAN = 128
BLOCK = 128
D_FF = ((8 * D_MODEL + 2) // 3 + 255) // 256 * 256
ROPE_THETA = 10000.0
NORM_EPS = 1e-6
NEG_INF = -1e30
Q_A_WIDTH = N_HEADS_A * HEAD_DIM
KV_A_WIDTH = N_KV_A * HEAD_DIM
B_WIDTH = N_GROUPS_B * HEADS_PER_GROUP_B * HEAD_DIM
OUT_B_WIDTH = HEADS_PER_GROUP_B * HEAD_DIM
N_IN = Q_A_WIDTH + 2 * KV_A_WIDTH + 3 * B_WIDTH + 2 * D_MODEL

kernel_name = "gated_swa_sink_dilated_hybrid_step"


def _rmsnorm(x, g):
    xf = x.astype(jnp.float32)
    y = xf * lax.rsqrt(jnp.mean(xf * xf, axis=-1, keepdims=True) + NORM_EPS)
    return (y * g.astype(jnp.float32)).astype(x.dtype)


def _rope(x, pos):
    half = HEAD_DIM // 2
    inv = 1.0 / (ROPE_THETA ** (jnp.arange(half, dtype=jnp.float32) / half))
    ang = pos.astype(jnp.float32)[:, None] * inv[None, :]
    ang = jnp.concatenate([ang, ang], axis=-1)
    shape = (1, pos.shape[0]) + (1,) * (x.ndim - 3) + (HEAD_DIM,)
    cos = jnp.cos(ang).reshape(shape)
    sin = jnp.sin(ang).reshape(shape)
    xf = x.astype(jnp.float32)
    rot = jnp.concatenate([-xf[..., half:], xf[..., :half]], axis=-1)
    return (xf * cos + rot * sin).astype(x.dtype)


def _lse(s, sink):
    lse = jax.nn.logsumexp(s, axis=-1)
    if sink is not None:
        lse = jnp.logaddexp(lse, sink.astype(jnp.float32))
    return lse


def _banded_attention(q, k, v, sink):
    N, L, Hk, G, Dh = q.shape
    nb = -(-L // BLOCK)
    Lp = nb * BLOCK
    pe = Lp - L
    qb = jnp.pad(q, ((0, 0), (0, pe), (0, 0), (0, 0), (0, 0))).reshape(N, nb, BLOCK, Hk, G, Dh)
    kb = jnp.pad(k, ((0, 0), (BLOCK, pe), (0, 0), (0, 0))).reshape(N, nb + 1, BLOCK, Hk, Dh)
    vb = jnp.pad(v, ((0, 0), (BLOCK, pe), (0, 0), (0, 0))).reshape(N, nb + 1, BLOCK, Hk, Dh)
    k_band = jnp.concatenate([kb[:, :-1], kb[:, 1:]], axis=2)
    v_band = jnp.concatenate([vb[:, :-1], vb[:, 1:]], axis=2)
    s = jnp.einsum('nbqhgd,nbkhd->nbhgqk', qb, k_band, preferred_element_type=jnp.float32) * (Dh ** -0.5)
    qi = jnp.arange(BLOCK)
    ki = jnp.arange(2 * BLOCK)
    dist = BLOCK + qi[:, None] - ki[None, :]
    key_pos = jnp.arange(nb)[:, None] * BLOCK - BLOCK + ki[None, :]
    mask = ((dist >= 0) & (dist <= SPAN))[None] & (key_pos >= 0)[:, None, :]
    s = jnp.where(mask[None, :, None, None], s, NEG_INF)
    lse = _lse(s, None if sink is None else sink[:, :, None])
    p = jnp.exp(s - lse[..., None])
    o = jnp.einsum('nbhgqk,nbkhd->nbqhgd', p.astype(v.dtype), v_band)
    o = o.reshape(N, Lp, Hk, G, Dh)[:, :L]
    lse = jnp.transpose(lse, (0, 1, 4, 2, 3)).reshape(N, Lp, Hk, G)[:, :L]
    return o, lse


def _gathered_attention(q, k_all, v_all, n_past, dilation, sink):
    S = q.shape[1]
    idx = n_past + jnp.arange(S)[:, None] - dilation * jnp.arange(SPAN + 1)[None, :]
    valid = idx >= 0
    idx = jnp.maximum(idx, 0)
    kg = jnp.take(k_all, idx, axis=1)
    vg = jnp.take(v_all, idx, axis=1)
    s = jnp.einsum('nshgd,nsjhd->nshgj', q, kg, preferred_element_type=jnp.float32) * (q.shape[-1] ** -0.5)
    s = jnp.where(valid[None, :, None, None, :], s, NEG_INF)
    lse = _lse(s, sink)
    p = jnp.exp(s - lse[..., None])
    o = jnp.einsum('nshgj,nsjhd->nshgd', p.astype(v_all.dtype), vg)
    return o, lse


def _to_residues(x, d):
    B, S = x.shape[:2]
    rest = x.shape[2:]
    x = jnp.swapaxes(x.reshape((B, S // d, d) + rest), 1, 2)
    return x.reshape((B * d, S // d) + rest)


def _from_residues(x, B, d):
    L = x.shape[1]
    rest = x.shape[2:]
    x = jnp.swapaxes(x.reshape((B, d, L) + rest), 1, 2)
    return x.reshape((B, L * d) + rest)


def _merge_dilated(outs, lses, dtype):
    alpha = jax.nn.softmax(jnp.stack(lses, axis=0), axis=0)
    o = jnp.einsum('gbshd,gbsh->bshd', jnp.stack(outs, axis=0).astype(jnp.float32), alpha)
    return o.astype(dtype)


def _project(x, pos, norm1_g, w_in):
    B, S, _ = x.shape
    h = _rmsnorm(x, norm1_g)
    z = h @ w_in
    o1 = Q_A_WIDTH
    o2 = o1 + KV_A_WIDTH
    o3 = o2 + KV_A_WIDTH
    o4 = o3 + B_WIDTH
    o5 = o4 + B_WIDTH
    o6 = o5 + B_WIDTH
    o7 = o6 + D_MODEL
    qa = _rope(z[..., :o1].reshape(B, S, N_KV_A, GROUP_A, HEAD_DIM), pos)
    ka = _rope(z[..., o1:o2].reshape(B, S, N_KV_A, HEAD_DIM), pos)
    va = z[..., o2:o3].reshape(B, S, N_KV_A, HEAD_DIM)
    qb = _rope(z[..., o3:o4].reshape(B, S, N_GROUPS_B, HEADS_PER_GROUP_B, HEAD_DIM), pos)
    kb = _rope(z[..., o4:o5].reshape(B, S, N_GROUPS_B, HEADS_PER_GROUP_B, HEAD_DIM), pos)
    vb = z[..., o5:o6].reshape(B, S, N_GROUPS_B, HEADS_PER_GROUP_B, HEAD_DIM)
    gate_a = jax.nn.sigmoid(z[..., o6:o7])
    gate_b = jax.nn.sigmoid(z[..., o7:])
    return qa, ka, va, qb, kb, vb, gate_a, gate_b


def _finish(x, oa, ob, gate_a, gate_b, w_pa, w_pb, w_o, norm2_g, w_gu, w_down):
    B, S, _ = x.shape
    m = gate_a * (oa.reshape(B, S, Q_A_WIDTH) @ w_pa) + gate_b * (ob.reshape(B, S, OUT_B_WIDTH) @ w_pb)
    x = x + m @ w_o
    gu = _rmsnorm(x, norm2_g) @ w_gu
    return x + (jax.nn.silu(gu[..., :D_FF]) * gu[..., D_FF:]) @ w_down


def _prompt_layer(x, norm1_g, w_in, sinks, w_pa, w_pb, w_o, norm2_g, w_gu, w_down):
    B, S, _ = x.shape
    pos = jnp.arange(S, dtype=jnp.int32)
    qa, ka, va, qb, kb, vb, gate_a, gate_b = _project(x, pos, norm1_g, w_in)
    oa, _ = _banded_attention(qa, ka, va, sinks.reshape(N_KV_A, GROUP_A))
    rows_a = min(WINDOW_A, S)
    state_a = jnp.stack([ka[:, S - rows_a:], va[:, S - rows_a:]], axis=2)
    outs, lses, states_b = [], [], []
    for gi, (win, dil) in enumerate(DILATED_PAIRS):
        q = _to_residues(qb[:, :, gi], dil)[:, :, :, None, :]
        o, lse = _banded_attention(q, _to_residues(kb[:, :, gi], dil), _to_residues(vb[:, :, gi], dil), None)
        outs.append(_from_residues(o[:, :, :, 0], B, dil))
        lses.append(_from_residues(lse[..., 0], B, dil))
        rows = min(win, S)
        states_b.append(jnp.stack([kb[:, S - rows:, gi], vb[:, S - rows:, gi]], axis=2))
    ob = _merge_dilated(outs, lses, x.dtype)
    y = _finish(x, oa, ob, gate_a, gate_b, w_pa, w_pb, w_o, norm2_g, w_gu, w_down)
    return y, state_a, states_b


def _sample_layer(x, cache_a, caches_b, norm1_g, w_in, sinks, w_pa, w_pb, w_o, norm2_g, w_gu, w_down):
    B, S, _ = x.shape
    pos = PAST_LEN + jnp.arange(S, dtype=jnp.int32)
    qa, ka, va, qb, kb, vb, gate_a, gate_b = _project(x, pos, norm1_g, w_in)
    k_all = jnp.concatenate([cache_a[:, :, 0], ka], axis=1)
    v_all = jnp.concatenate([cache_a[:, :, 1], va], axis=1)
    oa, _ = _gathered_attention(qa, k_all, v_all, cache_a.shape[1], 1, sinks.reshape(N_KV_A, GROUP_A))
    rows_a = min(WINDOW_A, PAST_LEN + S)
    n_a = k_all.shape[1]
    state_a = jnp.stack([k_all[:, n_a - rows_a:], v_all[:, n_a - rows_a:]], axis=2)
    outs, lses, states_b = [], [], []
    for gi, (win, dil) in enumerate(DILATED_PAIRS):
        cb = caches_b[gi]
        kg_all = jnp.concatenate([cb[:, :, 0], kb[:, :, gi]], axis=1)
        vg_all = jnp.concatenate([cb[:, :, 1], vb[:, :, gi]], axis=1)
        o, lse = _gathered_attention(qb[:, :, gi][:, :, :, None, :], kg_all, vg_all, cb.shape[1], dil, None)
        outs.append(o[:, :, :, 0])
        lses.append(lse[..., 0])
        rows = min(win, PAST_LEN + S)
        n_g = kg_all.shape[1]
        states_b.append(jnp.stack([kg_all[:, n_g - rows:], vg_all[:, n_g - rows:]], axis=2))
    ob = _merge_dilated(outs, lses, x.dtype)
    y = _finish(x, oa, ob, gate_a, gate_b, w_pa, w_pb, w_o, norm2_g, w_gu, w_down)
    return y, state_a, states_b


def setup_inputs(seed: int = 0) -> dict:
    key = jax.random.key(seed)
    ks = jax.random.split(key, 16)
    f32 = jnp.float32
    la = min(WINDOW_A, PAST_LEN)
    lb = [min(w, PAST_LEN) for (w, _) in DILATED_PAIRS]
    nrm = jax.random.normal
    return {
        "x_prompt": nrm(ks[0], (BATCH, SEQ, D_MODEL), f32),
        "x_sample": nrm(ks[1], (DEC_BATCH, DEC_SEQ, D_MODEL), f32),
        "cache_a_kv": nrm(ks[2], (DEPTH, DEC_BATCH, la, 2, N_KV_A, HEAD_DIM), f32),
        "cache_b1_kv": nrm(ks[3], (DEPTH, DEC_BATCH, lb[0], 2, HEADS_PER_GROUP_B, HEAD_DIM), f32),
        "cache_b2_kv": nrm(ks[4], (DEPTH, DEC_BATCH, lb[1], 2, HEADS_PER_GROUP_B, HEAD_DIM), f32),
        "cache_b3_kv": nrm(ks[5], (DEPTH, DEC_BATCH, lb[2], 2, HEADS_PER_GROUP_B, HEAD_DIM), f32),
        "norm1_g": 1.0 + 0.02 * nrm(ks[6], (DEPTH, D_MODEL), f32),
        "w_in": nrm(ks[7], (DEPTH, D_MODEL, N_IN), f32) * D_MODEL ** -0.5,
        "sinks": 0.5 * nrm(ks[8], (DEPTH, N_HEADS_A), f32),
        "w_pa": nrm(ks[9], (DEPTH, Q_A_WIDTH, D_MODEL), f32) * Q_A_WIDTH ** -0.5,
        "w_pb": nrm(ks[10], (DEPTH, OUT_B_WIDTH, D_MODEL), f32) * OUT_B_WIDTH ** -0.5,
        "w_o": nrm(ks[11], (DEPTH, D_MODEL, D_MODEL), f32) * D_MODEL ** -0.5,
        "norm2_g": 1.0 + 0.02 * nrm(ks[12], (DEPTH, D_MODEL), f32),
        "w_gu": nrm(ks[13], (DEPTH, D_MODEL, 2 * D_FF), f32) * D_MODEL ** -0.5,
        "w_down": nrm(ks[14], (DEPTH, D_FF, D_MODEL), f32) * D_FF ** -0.5,
        "final_norm_g": 1.0 + 0.02 * nrm(ks[15], (D_MODEL,), f32),
    }


def reference(x_prompt, x_sample, cache_a_kv, cache_b1_kv, cache_b2_kv, cache_b3_kv, norm1_g, w_in, sinks, w_pa, w_pb, w_o, norm2_g, w_gu, w_down, final_norm_g):
    xp = x_prompt
    xs = x_sample
    pa, pb1, pb2, pb3, sa, sb1, sb2, sb3 = [], [], [], [], [], [], [], []
    for l in range(DEPTH):
        xp, st_a, st_b = _prompt_layer(xp, norm1_g[l], w_in[l], sinks[l], w_pa[l], w_pb[l], w_o[l], norm2_g[l], w_gu[l], w_down[l])
        pa.append(st_a)
        pb1.append(st_b[0])
        pb2.append(st_b[1])
        pb3.append(st_b[2])
        xs, st_a, st_b = _sample_layer(xs, cache_a_kv[l], (cache_b1_kv[l], cache_b2_kv[l], cache_b3_kv[l]), norm1_g[l], w_in[l], sinks[l], w_pa[l], w_pb[l], w_o[l], norm2_g[l], w_gu[l], w_down[l])
        sa.append(st_a)
        sb1.append(st_b[0])
        sb2.append(st_b[1])
        sb3.append(st_b[2])
    y_prompt = _rmsnorm(xp, final_norm_g)
    y_sample = _rmsnorm(xs, final_norm_g)
    new_pa = jnp.stack(pa)
    new_pb1 = jnp.stack(pb1)
    new_pb2 = jnp.stack(pb2)
    new_pb3 = jnp.stack(pb3)
    new_sa = jnp.stack(sa)
    new_sb1 = jnp.stack(sb1)
    new_sb2 = jnp.stack(sb2)
    new_sb3 = jnp.stack(sb3)
    return (y_prompt, y_sample, new_pa, new_pb1, new_pb2, new_pb3, new_sa, new_sb1, new_sb2, new_sb3)
```

```cpp
#include <hip/hip_runtime.h>
#include <cstdio>
#include <cstdint>
namespace pg8 {
#define PG8_LAS __attribute__((address_space(3)))
typedef unsigned short bf16_t;
typedef short bf16x8 __attribute__((ext_vector_type(8)));
typedef float f32x4 __attribute__((ext_vector_type(4)));
typedef unsigned u32x4 __attribute__((ext_vector_type(4)));
constexpr int BM = 256, BK = 64, HALF = 128, HTB = HALF * BK * 2  , STAGE_BYTES = 8 * HTB, NXCD = 8, WGM = 8;

__host__ __device__ __forceinline__ int lds_byte(int r, int c) { const int st = (r >> 4) * 2 + (c >> 5), rr = r & 15, cc = c & 31, ob = rr * 64 + cc * 2; return st * 1024 + (ob ^ (((ob >> 9) & 1) << 5)); }
__host__ __device__ __forceinline__ void stage_rc(int b, int& R, int& C) { const int st = b / 1024, sb = b % 1024, swz = sb ^ (((sb >> 9) & 1) << 5); R = (st >> 1) * 16 + swz / 64; C = (st & 1) * 32 + (swz % 64) / 2; }
__host__ __device__ __forceinline__ int perm32(int rho) { const int n = rho >> 4, i = rho & 15; return 8 * (i >> 2) + 4 * n + (i & 3); }

struct Unit { int pm, pn; };
struct Gemm { const bf16_t* A; const bf16_t* Bt; int M, N, K; };

struct StaticOrder {
    int nM, nN, nwg, G, c;
    __host__ __device__ void init(int M, int N, int G_, int c_) { nM = M / BM; nN = N / BM; nwg = nM * nN; G = G_; c = c_; }
    __host__ __device__ bool next(int i, Unit& u) const {
        const long L = (long)i * G + c; if (L >= nwg) return false;
        int wgid = (int)L; { const int q = nwg / NXCD, r = nwg % NXCD, xcd = wgid % NXCD, off = wgid / NXCD; wgid = (xcd < r ? xcd * (q + 1) : r * (q + 1) + (xcd - r) * q) + off; }
        const int nig = WGM * nN, gid = wgid / nig, fm = gid * WGM, gsz = (nM - fm) < WGM ? (nM - fm) : WGM;
        u.pm = fm + ((wgid % nig) % gsz); u.pn = (wgid % nig) / gsz; return true;
    }
    __device__ __forceinline__ void a_ready(const Unit&) const {}
    __device__ __forceinline__ void done(const Unit&) const {}
};

__device__ __forceinline__ unsigned cvt_pk_bf16(float lo, float hi) { unsigned r; asm volatile("v_cvt_pk_bf16_f32 %0, %1, %2" : "=v"(r) : "v"(lo), "v"(hi)); return r; }
typedef float f32x2 __attribute__((ext_vector_type(2)));
template <class Epi, class Sched, bool ALIGN_EPI = false, bool SP2 = false>
__device__ __forceinline__ void gemm_phase(PG8_LAS unsigned char* lds, const Gemm g, const Sched& S, const Epi& E) {
    const int tid = threadIdx.x, wid = __builtin_amdgcn_readfirstlane(tid >> 6), lane = tid & 63, wr = wid >> 2, wc = wid & 3, fr = lane & 15, fq = lane >> 4;
    const int K = g.K, nt = K / BK;
    unsigned voffA[2], voffB[2];
#pragma unroll
    for (int i = 0; i < 2; ++i) { int R, C; stage_rc(tid * 16 + i * 8192, R, C); const int Rb = Epi::PERM ? ((R & ~31) + perm32(R & 31)) : R;
        voffA[i] = (unsigned)(R * K + C) * 2u; voffB[i] = (unsigned)(Rb * K + C) * 2u; }
    const size_t kstep = (size_t)(BK * 2);
    const size_t hstep = (size_t)HALF * K * 2;
    const size_t tstep = 2 * hstep;
    const unsigned ldsw = (unsigned)wid * 1024u;
    const int aoff = lds_byte(wr * 64 + fr, fq * 8), boff = lds_byte(wc * 32 + fr, fq * 8);
#define PG8_SA(b, h) (((b) * 2 + (h)) * HTB)
#define PG8_SB(b, h) ((4 + (b) * 2 + (h)) * HTB)
#define PG8_STAGE(bufoff, gbase, voff) do { _Pragma("unroll") for (int _i = 0; _i < 2; ++_i) \
        __builtin_amdgcn_global_load_lds((const unsigned*)((const char*)(gbase) + (voff)[_i]), (PG8_LAS unsigned*)(lds + (bufoff) + ldsw + _i * 8192), 16, 0, 0); } while (0)
#define PG8_LDA(dst, b, h) do { _Pragma("unroll") for (int m = 0; m < 4; ++m) _Pragma("unroll") for (int k = 0; k < 2; ++k) dst[m][k] = *(const PG8_LAS bf16x8*)(lds + PG8_SA(b, h) + aoff + m * 2048 + k * 1024); } while (0)
#define PG8_LDB(dst, b, h) do { _Pragma("unroll") for (int n = 0; n < 2; ++n) _Pragma("unroll") for (int k = 0; k < 2; ++k) dst[n][k] = *(const PG8_LAS bf16x8*)(lds + PG8_SB(b, h) + boff + n * 2048 + k * 1024); } while (0)
#define PG8_MMA(ai, bj, At, Bt) do { __builtin_amdgcn_s_setprio(1); _Pragma("unroll") for (int m = 0; m < 4; ++m) _Pragma("unroll") for (int n = 0; n < 2; ++n) _Pragma("unroll") for (int k = 0; k < 2; ++k) \
        acc[ai][bj][m][n] = __builtin_amdgcn_mfma_f32_16x16x32_bf16(Bt[n][k], At[m][k], acc[ai][bj][m][n], 0, 0, 0); __builtin_amdgcn_s_setprio(0); } while (0)
#define PG8_WAIT_V(n) asm volatile("s_waitcnt vmcnt(" #n ")" ::: "memory")
#define PG8_WAIT_L(n) asm volatile("s_waitcnt lgkmcnt(" #n ")" ::: "memory")
#define PG8_BAR __builtin_amdgcn_s_barrier()
#define PG8_SCHED __builtin_amdgcn_sched_barrier(0)
    Unit cur, nxt; int ui = 0;
    if (!S.next(0, cur)) return;
    f32x4 acc[2][2][4][2];
#pragma unroll
    for (int a = 0; a < 2; ++a)
#pragma unroll
        for (int b = 0; b < 2; ++b)
#pragma unroll
            for (int m = 0; m < 4; ++m)
#pragma unroll
                for (int n = 0; n < 2; ++n) acc[a][b][m][n] = (f32x4){0.f, 0.f, 0.f, 0.f};
    bf16x8 At[4][2], B0[2][2], B1[2][2];
    const char* cA = (const char*)g.A + (size_t)cur.pm * tstep; const char* cB = (const char*)g.Bt + (size_t)cur.pn * tstep;
    S.a_ready(cur);
    if constexpr (SP2) {
        PG8_STAGE(PG8_SB(0, 0), cB, voffB); PG8_STAGE(PG8_SB(0, 1), cB + hstep, voffB); PG8_STAGE(PG8_SA(0, 0), cA, voffA); PG8_STAGE(PG8_SA(0, 1), cA + hstep, voffA);
        if (wr == 1) PG8_BAR;
        PG8_WAIT_V(2); PG8_BAR;
        PG8_STAGE(PG8_SB(1, 0), cB + kstep, voffB); PG8_STAGE(PG8_SA(1, 0), cA + kstep, voffA); PG8_STAGE(PG8_SB(1, 1), cB + hstep + kstep, voffB);
        PG8_WAIT_V(6); PG8_BAR;
    } else {
        PG8_STAGE(PG8_SB(0, 0), cB, voffB); PG8_STAGE(PG8_SA(0, 0), cA, voffA); PG8_STAGE(PG8_SB(0, 1), cB + hstep, voffB); PG8_STAGE(PG8_SA(0, 1), cA + hstep, voffA);
        if (wr == 1) PG8_BAR;
        PG8_WAIT_V(4); PG8_BAR;
        PG8_STAGE(PG8_SB(1, 0), cB + kstep, voffB); PG8_STAGE(PG8_SA(1, 0), cA + kstep, voffA); PG8_STAGE(PG8_SB(1, 1), cB + hstep + kstep, voffB);
        PG8_WAIT_V(6); PG8_BAR;
    }
    for (;;) {
        const bool has_next = S.next(ui + 1, nxt);
        const char* nA = has_next ? (const char*)g.A + (size_t)nxt.pm * tstep : cA; const char* nB = has_next ? (const char*)g.Bt + (size_t)nxt.pn * tstep : cB;
        for (int t = 0; t < nt; t += 2) {
            const bool last = (t == nt - 2);
            const char* a1 = cA + (size_t)(t + 1) * kstep;
            const char* a2 = last ? nA : cA + (size_t)(t + 2) * kstep; const char* b2 = last ? nB : cB + (size_t)(t + 2) * kstep;
            const char* a3 = a2 + kstep; const char* b3 = b2 + kstep;
            if (last && has_next) S.a_ready(nxt);
            if constexpr (SP2) {
            PG8_LDB(B0, 0, 0); PG8_LDB(B1, 0, 1); PG8_SCHED; PG8_LDA(At, 0, 0); PG8_STAGE(PG8_SA(1, 1), a1 + hstep, voffA);
            PG8_WAIT_V(8); PG8_WAIT_L(0); PG8_BAR; PG8_MMA(0, 0, At, B0); PG8_MMA(0, 1, At, B1); PG8_BAR; PG8_SCHED;
            PG8_LDA(At, 0, 1); PG8_STAGE(PG8_SB(0, 0), b2, voffB); PG8_STAGE(PG8_SB(0, 1), b2 + hstep, voffB); PG8_STAGE(PG8_SA(0, 0), a2, voffA);
            PG8_WAIT_V(8); PG8_WAIT_L(0); PG8_BAR; PG8_MMA(1, 0, At, B0); PG8_MMA(1, 1, At, B1); PG8_BAR; PG8_SCHED;
            PG8_LDB(B0, 1, 0); PG8_LDB(B1, 1, 1); PG8_SCHED; PG8_LDA(At, 1, 0); PG8_STAGE(PG8_SA(0, 1), a2 + hstep, voffA);
            PG8_WAIT_V(8); PG8_WAIT_L(0); PG8_BAR; PG8_MMA(0, 0, At, B0); PG8_MMA(0, 1, At, B1); PG8_BAR; PG8_SCHED;
            PG8_LDA(At, 1, 1); PG8_STAGE(PG8_SB(1, 0), b3, voffB); PG8_STAGE(PG8_SB(1, 1), b3 + hstep, voffB); PG8_STAGE(PG8_SA(1, 0), a3, voffA);
            PG8_WAIT_V(8); PG8_WAIT_L(0); PG8_BAR; PG8_MMA(1, 0, At, B0); PG8_MMA(1, 1, At, B1); PG8_BAR; PG8_SCHED;
            } else {
            PG8_LDB(B0, 0, 0); PG8_SCHED; PG8_LDA(At, 0, 0); PG8_STAGE(PG8_SA(1, 1), a1 + hstep, voffA);
            PG8_WAIT_L(8); PG8_BAR; PG8_WAIT_L(0); PG8_MMA(0, 0, At, B0); PG8_BAR; PG8_SCHED;
            PG8_LDB(B1, 0, 1); PG8_STAGE(PG8_SB(0, 0), b2, voffB);
            PG8_BAR; PG8_WAIT_L(0); PG8_MMA(0, 1, At, B1); PG8_BAR;
            PG8_LDA(At, 0, 1); PG8_STAGE(PG8_SA(0, 0), a2, voffA);
            PG8_BAR; PG8_WAIT_L(0); PG8_MMA(1, 0, At, B0); PG8_BAR; PG8_SCHED;
            PG8_STAGE(PG8_SB(0, 1), b2 + hstep, voffB);
            PG8_WAIT_V(6); PG8_BAR; PG8_MMA(1, 1, At, B1); PG8_BAR;
            PG8_LDB(B0, 1, 0); PG8_SCHED; PG8_LDA(At, 1, 0); PG8_STAGE(PG8_SA(0, 1), a2 + hstep, voffA);
            PG8_WAIT_L(8); PG8_BAR; PG8_WAIT_L(0); PG8_MMA(0, 0, At, B0); PG8_BAR; PG8_SCHED;
            PG8_LDB(B1, 1, 1); PG8_STAGE(PG8_SB(1, 0), b3, voffB);
            PG8_BAR; PG8_WAIT_L(0); PG8_MMA(0, 1, At, B1); PG8_BAR;
            PG8_LDA(At, 1, 1); PG8_STAGE(PG8_SA(1, 0), a3, voffA);
            PG8_BAR; PG8_WAIT_L(0); PG8_MMA(1, 0, At, B0); PG8_BAR; PG8_SCHED;
            PG8_STAGE(PG8_SB(1, 1), b3 + hstep, voffB);
            PG8_WAIT_V(6); PG8_BAR; PG8_MMA(1, 1, At, B1); PG8_BAR;
            }
        }
        if constexpr (ALIGN_EPI) { if (wr == 0) PG8_BAR; }
        if constexpr (!Epi::AFTER_DRAIN) { E(acc, cur, wr, wc, fr, fq); S.done(cur); }
        if (!has_next) break;
#pragma unroll
        for (int a = 0; a < 2; ++a)
#pragma unroll
            for (int b = 0; b < 2; ++b)
#pragma unroll
                for (int m = 0; m < 4; ++m)
#pragma unroll
                    for (int n = 0; n < 2; ++n) acc[a][b][m][n] = (f32x4){0.f, 0.f, 0.f, 0.f};
        cur = nxt; cA = nA; cB = nB; ++ui;
        if constexpr (ALIGN_EPI) { if (wr == 1) PG8_BAR; }
    }
    PG8_WAIT_V(0);
    if constexpr (!ALIGN_EPI) { if (wr == 0) PG8_BAR; }
    PG8_BAR;
    if constexpr (Epi::AFTER_DRAIN) { E.fused(acc, cur, wr, wc, fr, fq, lds, wid, lane); S.done(cur); }
#undef PG8_SA
#undef PG8_SB
#undef PG8_STAGE
#undef PG8_LDA
#undef PG8_LDB
#undef PG8_MMA
#undef PG8_WAIT_V
#undef PG8_WAIT_L
#undef PG8_BAR
#undef PG8_SCHED
}
}
constexpr int DM = 1024, SEQ = 2048, NBATCH = 16, NPROMPT = NBATCH * SEQ, NSAMP = 128, PAST = 16384;
constexpr int MTOK = 129 * 256;
constexpr int NVALID = NPROMPT + NSAMP;
constexpr int NIN = 5632, DFF = 2816;
constexpr int ZQA = 0, ZKA = 1024, ZVA = 1152, ZQB = 1280, ZKB = 2048, ZVB = 2816, ZGA = 3584, ZGB = 4608;
constexpr float NORM_EPS = 1e-6f;
constexpr float LOG2E = 1.4426950408889634f;
constexpr float QSCALE = 0.125f * 1.4426950408889634f;
constexpr size_t O_Y = 0, O_PA = 33685504, O_PB1 = 34209792, O_PB2 = 35258368, O_PB3 = 39452672, O_SA = 56229888, O_SB1 = 60424192, O_SB2 = 68812800, O_SB3 = 102367232, O_END = 236584960;

namespace pg8 {
__device__ __forceinline__ float bf_lo(unsigned w) { return __uint_as_float(w << 16); }
__device__ __forceinline__ float bf_hi(unsigned w) { return __uint_as_float(w & 0xffff0000u); }
__device__ __forceinline__ float sigmoidf_(float x) { return __builtin_amdgcn_rcpf(1.0f + __builtin_amdgcn_exp2f(-x * LOG2E)); }

struct EpiIn {
    static constexpr bool PERM = true, AFTER_DRAIN = false;
    bf16_t* z; const float* cosT; const float* sinT; float* out;
    __device__ __forceinline__ void operator()(const f32x4 (&acc)[2][2][4][2], const Unit& u, int wr, int wc, int fr, int fq) const {
        const int pn = u.pn, pm = u.pm;
        int cls;
        if (pn < 4) cls = 0; else if (pn == 4) cls = (wc < 2) ? 1 : 2; else if (pn < 8) cls = 0; else if (pn < 11) cls = 1; else if (pn < 14) cls = 2; else cls = 3;
        const bool samp = (pm == 128);
        bool has_state = false; int rows_g = 0, HW = 0, head = 0, kv = 0; size_t obase = 0, sbase = 0;
        if (pn == 4) { has_state = true; rows_g = 128; HW = 128; head = wc & 1; kv = wc >> 1; obase = O_PA; sbase = O_SA; }
        else if (pn >= 8 && pn < 14) { const int g = (pn - 8) % 3; has_state = true; rows_g = 128 << (2 * g); HW = 256; head = wc; kv = (pn >= 11) ? 1 : 0;
            obase = (g == 0) ? O_PB1 : (g == 1) ? O_PB2 : O_PB3; sbase = (g == 0) ? O_SB1 : (g == 1) ? O_SB2 : O_SB3; }
#pragma unroll
        for (int ai = 0; ai < 2; ++ai) {
            if (samp && ai == 1) continue;
#pragma unroll
            for (int m = 0; m < 4; ++m) {
                const int r = ai * HALF + wr * 64 + m * 16 + fr; const int token = pm * BM + r;
                const int posidx = samp ? 2048 : (token & 2047);
                f32x4 lo0 = acc[ai][0][m][0], lo1 = acc[ai][0][m][1], hi0 = acc[ai][1][m][0], hi1 = acc[ai][1][m][1];
                if (cls <= 1) {
                    const f32x4 c0 = *(const f32x4*)(cosT + posidx * 32 + 8 * fq), c1 = *(const f32x4*)(cosT + posidx * 32 + 8 * fq + 4);
                    const f32x4 s0 = *(const f32x4*)(sinT + posidx * 32 + 8 * fq), s1 = *(const f32x4*)(sinT + posidx * 32 + 8 * fq + 4);
                    const f32x4 a0 = lo0 * c0 - hi0 * s0, b0 = hi0 * c0 + lo0 * s0, a1 = lo1 * c1 - hi1 * s1, b1 = hi1 * c1 + lo1 * s1;
                    lo0 = a0; hi0 = b0; lo1 = a1; hi1 = b1;
                    if (cls == 0) { lo0 = lo0 * QSCALE; lo1 = lo1 * QSCALE; hi0 = hi0 * QSCALE; hi1 = hi1 * QSCALE; }
                } else if (cls == 3) {
#pragma unroll
                    for (int e = 0; e < 4; ++e) { lo0[e] = sigmoidf_(lo0[e]); lo1[e] = sigmoidf_(lo1[e]); hi0[e] = sigmoidf_(hi0[e]); hi1[e] = sigmoidf_(hi1[e]); }
                }
                bf16_t* zp = z + (size_t)token * NIN + pn * 256 + wc * 64 + 8 * fq;
                u32x4 w; w.x = cvt_pk_bf16(lo0[0], lo0[1]); w.y = cvt_pk_bf16(lo0[2], lo0[3]); w.z = cvt_pk_bf16(lo1[0], lo1[1]); w.w = cvt_pk_bf16(lo1[2], lo1[3]);
                *(u32x4*)zp = w;
                w.x = cvt_pk_bf16(hi0[0], hi0[1]); w.y = cvt_pk_bf16(hi0[2], hi0[3]); w.z = cvt_pk_bf16(hi1[0], hi1[1]); w.w = cvt_pk_bf16(hi1[2], hi1[3]);
                *(u32x4*)(zp + 32) = w;
                if (has_state) {
                    float* dst = nullptr;
                    if (samp) { dst = out + sbase + ((size_t)(r * rows_g + rows_g - 1) * 2 + kv) * HW + head * 64; }
                    else { const int b = token >> 11, pos = token & 2047, rr = pos - (SEQ - rows_g);
                        if (rr >= 0) dst = out + obase + ((size_t)(b * rows_g + rr) * 2 + kv) * HW + head * 64; }
                    if (dst) { *(f32x4*)(dst + 8 * fq) = lo0; *(f32x4*)(dst + 8 * fq + 4) = lo1; *(f32x4*)(dst + 32 + 8 * fq) = hi0; *(f32x4*)(dst + 32 + 8 * fq + 4) = hi1; }
                }
            }
        }
    }
};

struct EpiGateB {
    static constexpr bool PERM = true, AFTER_DRAIN = false;
    const bf16_t* z; float* tmp;
    __device__ __forceinline__ void operator()(const f32x4 (&acc)[2][2][4][2], const Unit& u, int wr, int wc, int fr, int fq) const {
#pragma unroll
        for (int ai = 0; ai < 2; ++ai)
#pragma unroll
            for (int m = 0; m < 4; ++m) {
                const int token = u.pm * BM + ai * HALF + wr * 64 + m * 16 + fr;
#pragma unroll
                for (int bj = 0; bj < 2; ++bj) {
                    const int col = u.pn * BM + bj * HALF + wc * 32 + 8 * fq;
                    const u32x4 gw = *(const u32x4*)(z + (size_t)token * NIN + ZGB + col);
                    f32x4 v0 = acc[ai][bj][m][0], v1 = acc[ai][bj][m][1];
                    v0[0] *= bf_lo(gw.x); v0[1] *= bf_hi(gw.x); v0[2] *= bf_lo(gw.y); v0[3] *= bf_hi(gw.y);
                    v1[0] *= bf_lo(gw.z); v1[1] *= bf_hi(gw.z); v1[2] *= bf_lo(gw.w); v1[3] *= bf_hi(gw.w);
                    float* tp = tmp + (size_t)token * DM + col; *(f32x4*)tp = v0; *(f32x4*)(tp + 4) = v1;
                }
            }
    }
};
struct EpiGateA {
    static constexpr bool PERM = true, AFTER_DRAIN = false;
    const bf16_t* z; const float* tmp; bf16_t* mb;
    __device__ __forceinline__ void operator()(const f32x4 (&acc)[2][2][4][2], const Unit& u, int wr, int wc, int fr, int fq) const {
#pragma unroll
        for (int ai = 0; ai < 2; ++ai)
#pragma unroll
            for (int m = 0; m < 4; ++m) {
                const int token = u.pm * BM + ai * HALF + wr * 64 + m * 16 + fr;
#pragma unroll
                for (int bj = 0; bj < 2; ++bj) {
                    const int col = u.pn * BM + bj * HALF + wc * 32 + 8 * fq;
                    const u32x4 gw = *(const u32x4*)(z + (size_t)token * NIN + ZGA + col);
                    const float* tp = tmp + (size_t)token * DM + col; const f32x4 t0 = *(const f32x4*)tp, t1 = *(const f32x4*)(tp + 4);
                    f32x4 v0 = acc[ai][bj][m][0], v1 = acc[ai][bj][m][1];
                    v0[0] = v0[0] * bf_lo(gw.x) + t0[0]; v0[1] = v0[1] * bf_hi(gw.x) + t0[1]; v0[2] = v0[2] * bf_lo(gw.y) + t0[2]; v0[3] = v0[3] * bf_hi(gw.y) + t0[3];
                    v1[0] = v1[0] * bf_lo(gw.z) + t1[0]; v1[1] = v1[1] * bf_hi(gw.z) + t1[1]; v1[2] = v1[2] * bf_lo(gw.w) + t1[2]; v1[3] = v1[3] * bf_hi(gw.w) + t1[3];
                    u32x4 w; w.x = cvt_pk_bf16(v0[0], v0[1]); w.y = cvt_pk_bf16(v0[2], v0[3]); w.z = cvt_pk_bf16(v1[0], v1[1]); w.w = cvt_pk_bf16(v1[2], v1[3]);
                    *(u32x4*)(mb + (size_t)token * DM + col) = w;
                }
            }
    }
};
struct EpiWo {
    static constexpr bool PERM = true, AFTER_DRAIN = false;
    const float* xp; const float* xs; const float* g2; float* x1; bf16_t* xb2; float* rowsq;
    __device__ __forceinline__ void operator()(const f32x4 (&acc)[2][2][4][2], const Unit& u, int wr, int wc, int fr, int fq) const {
        f32x4 gv[2][2];
#pragma unroll
        for (int bj = 0; bj < 2; ++bj)
#pragma unroll
            for (int n = 0; n < 2; ++n) gv[bj][n] = *(const f32x4*)(g2 + u.pn * BM + bj * HALF + wc * 32 + 8 * fq + 4 * n);
#pragma unroll
        for (int ai = 0; ai < 2; ++ai)
#pragma unroll
            for (int m = 0; m < 4; ++m) {
                const int token = u.pm * BM + ai * HALF + wr * 64 + m * 16 + fr;
                const float* xr = (token < NPROMPT) ? xp + (size_t)token * DM : xs + (size_t)(token - NPROMPT) * DM;
                const bool valid = token < NVALID;
                float ss = 0.f;
#pragma unroll
                for (int bj = 0; bj < 2; ++bj) {
                    const int col = u.pn * BM + bj * HALF + wc * 32 + 8 * fq;
                    f32x4 a0 = (f32x4){0.f, 0.f, 0.f, 0.f}, a1 = a0;
                    if (valid) { a0 = *(const f32x4*)(xr + col); a1 = *(const f32x4*)(xr + col + 4); }
                    const f32x4 v0 = acc[ai][bj][m][0] + a0, v1 = acc[ai][bj][m][1] + a1;
                    ss += (v0[0] * v0[0] + v0[1] * v0[1]) + (v0[2] * v0[2] + v0[3] * v0[3]) + (v1[0] * v1[0] + v1[1] * v1[1]) + (v1[2] * v1[2] + v1[3] * v1[3]);
                    float* op = x1 + (size_t)token * DM + col; *(f32x4*)op = v0; *(f32x4*)(op + 4) = v1;
                    const f32x4 s0 = v0 * gv[bj][0], s1 = v1 * gv[bj][1];
                    u32x4 w; w.x = cvt_pk_bf16(s0[0], s0[1]); w.y = cvt_pk_bf16(s0[2], s0[3]); w.z = cvt_pk_bf16(s1[0], s1[1]); w.w = cvt_pk_bf16(s1[2], s1[3]);
                    *(u32x4*)(xb2 + (size_t)token * DM + col) = w;
                }
                ss += __shfl_xor(ss, 16); ss += __shfl_xor(ss, 32);
                if (fq == 0) atomicAdd(rowsq + token, ss);
            }
    }
};
struct EpiGU {
    static constexpr bool PERM = true, AFTER_DRAIN = false;
    const float* rowsq; bf16_t* hh;
    __device__ __forceinline__ void operator()(const f32x4 (&acc)[2][2][4][2], const Unit& u, int wr, int wc, int fr, int fq) const {
#pragma unroll
        for (int ai = 0; ai < 2; ++ai)
#pragma unroll
            for (int m = 0; m < 4; ++m) {
                const int token = u.pm * BM + ai * HALF + wr * 64 + m * 16 + fr;
                const float rs = __builtin_amdgcn_rsqf(rowsq[token] * (1.0f / DM) + NORM_EPS);
                f32x4 o[2];
#pragma unroll
                for (int n = 0; n < 2; ++n) {
                    const f32x4 g = acc[ai][0][m][n] * rs, uu = acc[ai][1][m][n] * rs;
#pragma unroll
                    for (int e = 0; e < 4; ++e) o[n][e] = g[e] * uu[e] * sigmoidf_(g[e]);
                }
                u32x4 w; w.x = cvt_pk_bf16(o[0][0], o[0][1]); w.y = cvt_pk_bf16(o[0][2], o[0][3]); w.z = cvt_pk_bf16(o[1][0], o[1][1]); w.w = cvt_pk_bf16(o[1][2], o[1][3]);
                *(u32x4*)(hh + (size_t)token * DFF + u.pn * HALF + wc * 32 + 8 * fq) = w;
            }
    }
};
struct EpiDown {
    static constexpr bool PERM = true, AFTER_DRAIN = false;
    const float* x1; const float* gf; float* out; float* rowsq;
    __device__ __forceinline__ void operator()(const f32x4 (&acc)[2][2][4][2], const Unit& u, int wr, int wc, int fr, int fq) const {
        f32x4 gv[2][2];
#pragma unroll
        for (int bj = 0; bj < 2; ++bj)
#pragma unroll
            for (int n = 0; n < 2; ++n) gv[bj][n] = *(const f32x4*)(gf + u.pn * BM + bj * HALF + wc * 32 + 8 * fq + 4 * n);
#pragma unroll
        for (int ai = 0; ai < 2; ++ai)
#pragma unroll
            for (int m = 0; m < 4; ++m) {
                const int token = u.pm * BM + ai * HALF + wr * 64 + m * 16 + fr;
                if (token >= NVALID) continue;
                float ss = 0.f;
#pragma unroll
                for (int bj = 0; bj < 2; ++bj) {
                    const int col = u.pn * BM + bj * HALF + wc * 32 + 8 * fq;
                    const float* xr = x1 + (size_t)token * DM + col;
                    const f32x4 v0 = acc[ai][bj][m][0] + *(const f32x4*)xr, v1 = acc[ai][bj][m][1] + *(const f32x4*)(xr + 4);
                    ss += (v0[0] * v0[0] + v0[1] * v0[1]) + (v0[2] * v0[2] + v0[3] * v0[3]) + (v1[0] * v1[0] + v1[1] * v1[1]) + (v1[2] * v1[2] + v1[3] * v1[3]);
                    float* op = out + O_Y + (size_t)token * DM + col; *(f32x4*)op = v0 * gv[bj][0]; *(f32x4*)(op + 4) = v1 * gv[bj][1];
                }
                ss += __shfl_xor(ss, 16); ss += __shfl_xor(ss, 32);
                if (fq == 0) atomicAdd(rowsq + token, ss);
            }
    }
};
}
#define GAS __attribute__((address_space(1)))
#define LAS __attribute__((address_space(3)))
typedef unsigned short bf16;
typedef unsigned v4u __attribute__((ext_vector_type(4)));
typedef float f32x4 __attribute__((ext_vector_type(4)));
typedef short bf16x8 __attribute__((ext_vector_type(8)));
typedef GAS unsigned gu32;
typedef GAS unsigned long long gu64;
#define RLX_AGENT __ATOMIC_RELAXED, __HIP_MEMORY_SCOPE_AGENT
#define LDS_WAIT() asm volatile("s_waitcnt lgkmcnt(0)" ::: "memory")
#define VM_WAIT() asm volatile("s_waitcnt vmcnt(0)" ::: "memory")
__device__ __forceinline__ unsigned long long rt() { return __builtin_amdgcn_s_memrealtime(); }
__device__ __forceinline__ unsigned f2bf(float f) { unsigned u = __builtin_bit_cast(unsigned, f); return (u + 0x7fffu + ((u >> 16) & 1u)) >> 16; }
__device__ __forceinline__ unsigned pk2(float lo, float hi) { return f2bf(lo) | (f2bf(hi) << 16); }

#define XB_TMO      128
#define XB_XCNT(j)  (256  + 64 * (j))
#define XB_XSUB(j)  (1280 + 64 * (j))
#define XB_XGEN(j)  (2304 + 64 * (j))
#define XB_TOP      3328
#define XB_TOPGEN   3392
#define XCD_BAR_WORDS 3456
#define XB_SPIN_CAP (1u << 18)

__device__ __forceinline__ unsigned xb_ld(unsigned* p)              { return __hip_atomic_load(p, __ATOMIC_RELAXED, __HIP_MEMORY_SCOPE_AGENT); }
__device__ __forceinline__ unsigned xb_add(unsigned* p, unsigned v) { return __hip_atomic_fetch_add(p, v, __ATOMIC_RELAXED, __HIP_MEMORY_SCOPE_AGENT); }
__device__ __forceinline__ unsigned xb_xcc_id() { return (unsigned)__builtin_amdgcn_s_getreg((3 << 11) | 20) & 0xFu; }
#define XB_SPIN(cond, bar) do { unsigned _sp = 0; while (cond) { __builtin_amdgcn_s_sleep(1); \
    if ((++_sp & 255u) == 0u) { if (xb_ld(&(bar)[XB_TMO])) break; if (_sp > XB_SPIN_CAP) { atomicAdd(&(bar)[XB_TMO], 1u); break; } } } } while (0)

struct XcdBarrier {
    unsigned* bar; unsigned x;
    volatile LAS unsigned* st;
};

__device__ __forceinline__ XcdBarrier xcd_barrier_post(unsigned* bar, volatile LAS unsigned* st) {
    XcdBarrier b; b.bar = bar; b.x = xb_xcc_id(); b.st = st;
    if (threadIdx.x == 0) (void)xb_add(&bar[XB_XCNT(b.x)], 1u);
    return b;
}
__device__ __forceinline__ void xcd_barrier_complete(unsigned* bar, unsigned x, unsigned& nloc, unsigned& nx) {
    const unsigned G = gridDim.x * gridDim.y * gridDim.z;
    unsigned sum, cnt, mine, sp = 0u;
    for (;;) {
        sum = 0u; cnt = 0u; mine = 0u;
#pragma unroll
        for (unsigned j = 0; j < 16; ++j) { const unsigned c = xb_ld(&bar[XB_XCNT(j)]); sum += c; cnt += (c > 0u) ? 1u : 0u; mine = (j == x) ? c : mine; }
        if (sum == G) break;
        __builtin_amdgcn_s_sleep(1);
        if ((++sp & 255u) == 0u) { if (xb_ld(&bar[XB_TMO])) break; if (sp > XB_SPIN_CAP) { atomicAdd(&bar[XB_TMO], 1u); break; } }
    }
    nloc = mine > 0u ? mine : 1u; nx = cnt > 0u ? cnt : 1u;
}

__device__ __forceinline__ void xcd_barrier(const XcdBarrier& b) {
    asm volatile("s_waitcnt vmcnt(0)" ::: "memory");
    __syncthreads();
    if (threadIdx.x == 0) {
        unsigned* bar = b.bar;
        __builtin_amdgcn_s_waitcnt(0);
        unsigned nloc = b.st[0], nx = b.st[1];
        if (nloc == 0u) { xcd_barrier_complete(bar, b.x, nloc, nx); b.st[0] = nloc; b.st[1] = nx; }
        const unsigned old = xb_add(&bar[XB_XSUB(b.x)], 1u);
        const unsigned gen = old / nloc;
        if (old + 1u == (gen + 1u) * nloc) {
            __builtin_amdgcn_fence(__ATOMIC_RELEASE, "agent");
            asm volatile("s_waitcnt vmcnt(0)" ::: "memory");
            const unsigned og = xb_add(&bar[XB_TOP], 1u);
            const unsigned tg = og / nx;
            if (og + 1u == (tg + 1u) * nx) xb_add(&bar[XB_TOPGEN], 1u);
            else XB_SPIN(xb_ld(&bar[XB_TOPGEN]) == tg, bar);
            __builtin_amdgcn_fence(__ATOMIC_ACQUIRE, "agent");
            xb_add(&bar[XB_XGEN(b.x)], 1u);
            asm volatile("s_waitcnt vmcnt(0)" ::: "memory");
        } else {
            XB_SPIN(xb_ld(&bar[XB_XGEN(b.x)]) == gen, bar);
            __builtin_amdgcn_fence(__ATOMIC_ACQUIRE, "agent");
            asm volatile("s_waitcnt vmcnt(0)" ::: "memory");
        }
    }
    __syncthreads();
}
__device__ __forceinline__ float bf2f(bf16 v) { return __uint_as_float((unsigned)v << 16); }
namespace att {
typedef float f32x16 __attribute__((ext_vector_type(16)));
typedef short bf16x8 __attribute__((ext_vector_type(8)));
typedef short s16x4 __attribute__((ext_vector_type(4)));
typedef short v4i16_t __attribute__((ext_vector_type(4)));
typedef unsigned u32x4 __attribute__((ext_vector_type(4)));
typedef unsigned u32x2 __attribute__((ext_vector_type(2)));
constexpr int KP = 144;
constexpr int LK = 0, LV = 384 * KP;
constexpr int LSC = LV + 12 * 4096;
constexpr int ATT_LDS = LSC + 8 * 1024;
__device__ __forceinline__ int crow(int r, int hi) { return (r & 3) + 8 * (r >> 2) + 4 * hi; }
__device__ __forceinline__ s16x4 vtr(LAS const unsigned char* p) { return __builtin_bit_cast(s16x4, __builtin_amdgcn_ds_read_tr16_b64_v4i16((LAS v4i16_t*)p)); }
__device__ __forceinline__ unsigned pkbf(float lo, float hi) { typedef float f2 __attribute__((ext_vector_type(2))); typedef __bf16 b2 __attribute__((ext_vector_type(2))); f2 v = {lo, hi}; b2 b = __builtin_convertvector(v, b2); return __builtin_bit_cast(unsigned, b); }
__device__ __forceinline__ float swapmax(float m) { auto rr = __builtin_amdgcn_permlane32_swap(__float_as_uint(m), __float_as_uint(m), false, false); return fmaxf(__uint_as_float(rr[0]), __uint_as_float(rr[1])); }
__device__ __forceinline__ float swapsum(float m) { auto rr = __builtin_amdgcn_permlane32_swap(__float_as_uint(m), __float_as_uint(m), false, false); return __uint_as_float(rr[0]) + __uint_as_float(rr[1]); }

struct SlotMap { int mode, base, r, n0; };
__device__ __forceinline__ int slot_token(const SlotMap& sm, int s) {
    if (sm.mode == 2) return sm.base + sm.r + (s >> 7) + 16 * (s & 127);
    const int n = sm.n0 - 128 + s; if (n < 0) return -1;
    return sm.base + sm.r + (sm.mode == 1 ? 4 * n : n);
}
template <int ITERS>
__device__ __forceinline__ void stage_kv(LAS unsigned char* lds, const bf16* z, int kcol, int vcol, int nslots, const SlotMap sm, int tid) {
    u32x4 kq[ITERS], vq[ITERS]; int ok[ITERS];
#pragma unroll
    for (int it = 0; it < ITERS; ++it) {
        const int id = tid + it * 512; const int s = id >> 3, c = id & 7; ok[it] = 0;
        if (id < nslots * 8) { const int tok = slot_token(sm, s);
            if (tok >= 0) { const bf16* rp = z + (size_t)tok * NIN + c * 8; kq[it] = *(const u32x4*)(rp + kcol); vq[it] = *(const u32x4*)(rp + vcol); ok[it] = 1; } }
    }
#pragma unroll
    for (int it = 0; it < ITERS; ++it) {
        const int id = tid + it * 512; const int s = id >> 3, c = id & 7;
        if (ok[it]) { *(LAS u32x4*)(lds + LK + s * KP + c * 16) = kq[it];
            *(LAS u32x4*)(lds + LV + (s >> 5) * 4096 + (c >> 2) * 2048 + (s & 31) * 64 + (c & 3) * 16) = vq[it]; }
    }
}
__device__ __forceinline__ void attn_wave(LAS unsigned char* lds, const bf16* qrow, int slot_base, int t_lo, bool has_sink, float sink2, bf16* orow, float* lsep, int lane) {
    const int i = lane & 31, h = lane >> 5;
    bf16x8 qr[4];
#pragma unroll
    for (int ks = 0; ks < 4; ++ks) qr[ks] = *(const bf16x8*)(qrow + 16 * ks + 8 * h);
    f32x16 st[5];
    const float NEG = -INFINITY;
#pragma unroll
    for (int t = 0; t < 5; ++t) {
        if (t >= t_lo) {
            LAS const unsigned char* kp = lds + LK + (slot_base + 32 * t + i) * KP + h * 16;
            f32x16 acc = {};
#pragma unroll
            for (int ks = 0; ks < 4; ++ks) { const bf16x8 kf = *(LAS const bf16x8*)(kp + ks * 32); acc = __builtin_amdgcn_mfma_f32_32x32x16_bf16(kf, qr[ks], acc, 0, 0, 0); }
            st[t] = acc;
        } else {
#pragma unroll
            for (int r = 0; r < 16; ++r) st[t][r] = NEG;
        }
    }
#pragma unroll
    for (int r = 0; r < 16; ++r) { const int j = crow(r, h); if (j < i) st[0][r] = NEG; if (j > i) st[4][r] = NEG; }
    float m = NEG;
#pragma unroll
    for (int t = 0; t < 5; ++t)
#pragma unroll
        for (int r = 0; r < 16; ++r) m = fmaxf(m, st[t][r]);
    m = swapmax(m);
    if (has_sink) m = fmaxf(m, sink2);
    float l = 0.f;
#pragma unroll
    for (int t = 0; t < 5; ++t)
#pragma unroll
        for (int r = 0; r < 16; ++r) { st[t][r] = __builtin_amdgcn_exp2f(st[t][r] - m); l += st[t][r]; }
    l = swapsum(l);
    if (has_sink) l += __builtin_amdgcn_exp2f(sink2 - m);
    f32x16 o[2]; o[0] = (f32x16){}; o[1] = (f32x16){};
    const int vlane = (4 * h + ((lane & 15) >> 2)) * 64 + ((lane >> 4) & 1) * 32 + (lane & 3) * 8;
#pragma unroll
    for (int t = 0; t < 5; ++t) {
        if (t >= t_lo) {
            LAS const unsigned char* vt = lds + LV + ((slot_base >> 5) + t) * 4096 + vlane;
#pragma unroll
            for (int s = 0; s < 2; ++s) {
                u32x4 pw; pw.x = pkbf(st[t][8 * s + 0], st[t][8 * s + 1]); pw.y = pkbf(st[t][8 * s + 2], st[t][8 * s + 3]); pw.z = pkbf(st[t][8 * s + 4], st[t][8 * s + 5]); pw.w = pkbf(st[t][8 * s + 6], st[t][8 * s + 7]);
                const bf16x8 pb = __builtin_bit_cast(bf16x8, pw);
#pragma unroll
                for (int blk = 0; blk < 2; ++blk) {
                    const s16x4 lo = vtr(vt + blk * 2048 + s * 1024), hi = vtr(vt + blk * 2048 + s * 1024 + 512);
                    const bf16x8 va = (bf16x8){lo[0], lo[1], lo[2], lo[3], hi[0], hi[1], hi[2], hi[3]};
                    o[blk] = __builtin_amdgcn_mfma_f32_32x32x16_bf16(va, pb, o[blk], 0, 0, 0);
                }
            }
        }
    }
    const float inv = 1.0f / l;
#pragma unroll
    for (int blk = 0; blk < 2; ++blk)
#pragma unroll
        for (int rg = 0; rg < 4; ++rg) {
            u32x2 w; w.x = pkbf(o[blk][4 * rg + 0] * inv, o[blk][4 * rg + 1] * inv); w.y = pkbf(o[blk][4 * rg + 2] * inv, o[blk][4 * rg + 3] * inv);
            *(u32x2*)(orow + 32 * blk + 8 * rg + 4 * h) = w;
        }
    if (lsep && h == 0) *lsep = m + __builtin_amdgcn_logf(l);
}
__device__ __forceinline__ float wsum(float v) {
#pragma unroll
    for (int o = 1; o < 64; o <<= 1) v += __shfl_xor(v, o);
    return v;
}
__device__ __forceinline__ float wmax(float v) {
#pragma unroll
    for (int o = 1; o < 64; o <<= 1) v = fmaxf(v, __shfl_xor(v, o));
    return v;
}
__device__ __forceinline__ void sample_wave(LAS float* sc, const bf16* zrow, int qcol, int kcol, int vcol, const float* kc, const float* vc, int W, int d, int rp, bool has_sink, float sink2, bf16* orow, float* lsep, int lane) {
    const float q = bf2f(zrow[qcol + lane]), kn = bf2f(zrow[kcol + lane]), vn = bf2f(zrow[vcol + lane]);
    sc[lane] = q;
    asm volatile("s_waitcnt lgkmcnt(0)" ::: "memory");
    const float s0 = wsum(q * kn);
    float sA = 0.f, sB = 0.f;
    { const float* ka = kc + (size_t)(W - d * (1 + lane)) * rp; const float* kb = kc + (size_t)(W - d * (65 + lane)) * rp;
#pragma unroll 4
      for (int c = 0; c < 16; ++c) { const f32x4 qa = *(LAS const f32x4*)(sc + 4 * c); const f32x4 a = *(const f32x4*)(ka + 4 * c), b = *(const f32x4*)(kb + 4 * c);
          sA += qa[0] * a[0] + qa[1] * a[1] + qa[2] * a[2] + qa[3] * a[3]; sB += qa[0] * b[0] + qa[1] * b[1] + qa[2] * b[2] + qa[3] * b[3]; } }
    float m = fmaxf(wmax(fmaxf(sA, sB)), s0); if (has_sink) m = fmaxf(m, sink2);
    const float pA = __builtin_amdgcn_exp2f(sA - m), pB = __builtin_amdgcn_exp2f(sB - m), p0 = __builtin_amdgcn_exp2f(s0 - m);
    float l = wsum(pA + pB) + p0; if (has_sink) l += __builtin_amdgcn_exp2f(sink2 - m);
    sc[64 + 1 + lane] = pA; sc[64 + 65 + lane] = pB;
    asm volatile("s_waitcnt lgkmcnt(0)" ::: "memory");
    float o = p0 * vn;
#pragma unroll 8
    for (int jj = 1; jj <= 128; ++jj) o += sc[64 + jj] * vc[(size_t)(W - d * jj) * rp + lane];
    orow[lane] = f2bf(o / l);
    if (lsep && lane == 0) *lsep = m + __builtin_amdgcn_logf(l);
    asm volatile("s_waitcnt lgkmcnt(0)" ::: "memory");
}
}

constexpr size_t MiB = 1u << 20;
constexpr size_t WS_CTL = 0, CTL_ZERO_BYTES = 1 * MiB;
constexpr size_t WS_ROPE = 2 * MiB;
constexpr size_t WS_WIN = 4 * MiB, WS_WGU = 16 * MiB, WS_WDN = 28 * MiB, WS_WPA = 34 * MiB, WS_WPB = 36 * MiB, WS_WO = 37 * MiB;
constexpr size_t WS_LSE = 40 * MiB;
constexpr size_t WS_XN = 64 * MiB, WS_Z = 130 * MiB, WS_OA = 486 * MiB, WS_OB = 552 * MiB, WS_OG = 570 * MiB, WS_TMP = 620 * MiB, WS_MB = 750 * MiB;
constexpr size_t WS_X1 = 816 * MiB, WS_XB2 = 946 * MiB, WS_HH = 1012 * MiB, WS_END = 1190 * MiB;
constexpr int CW_BAR = 4096;
constexpr int CW_RSQ2 = 65536, CW_RSQ3 = 131072;
static_assert((CW_RSQ3 + MTOK) * 4 <= (int)CTL_ZERO_BYTES, "ctl");

constexpr int RING_BYTES = 131072, MISC_OFF = RING_BYTES + 320, LDS_BYTES = 147456;
constexpr int NWAVES = 8;
constexpr int NPHASE = 10;

__device__ const double INVF[32] = {1.0, 0.7498942093324559, 0.5623413251903491, 0.4216965034285822, 0.31622776601683794, 0.23713737056616552, 0.1778279410038923, 0.1333521432163324, 0.1, 0.07498942093324558, 0.05623413251903491, 0.042169650342858224, 0.03162277660168379, 0.023713737056616554, 0.01778279410038923, 0.01333521432163324, 0.01, 0.007498942093324558, 0.005623413251903491, 0.004216965034285823, 0.0031622776601683794, 0.0023713737056616554, 0.0017782794100389228, 0.001333521432163324, 0.001, 0.0007498942093324559, 0.0005623413251903491, 0.00042169650342858224, 0.00031622776601683794, 0.00023713737056616554, 0.00017782794100389227, 0.0001333521432163324};

__device__ __forceinline__ void sincos_d(double x, double& s, double& c) {
    const double n = __builtin_rint(x * 0.63661977236758134308);
    double r = x - n * 1.57079632679489655800e+00; r = r - n * 6.12323399573676603587e-17;
    const double r2 = r * r;
    double sp = -7.6471637318198164759e-13; sp = sp * r2 + 1.6059043836821614599e-10; sp = sp * r2 - 2.5052108385441718775e-08; sp = sp * r2 + 2.7557319223985890653e-06;
    sp = sp * r2 - 1.9841269841269841270e-04; sp = sp * r2 + 8.3333333333333333333e-03; sp = sp * r2 - 1.6666666666666666667e-01; const double sr = r + r * r2 * sp;
    double cp = 4.7794773323873852974e-14; cp = cp * r2 - 1.1470745597729724714e-11; cp = cp * r2 + 2.0876756987868098979e-09; cp = cp * r2 - 2.7557319223985890653e-07;
    cp = cp * r2 + 2.4801587301587301587e-05; cp = cp * r2 - 1.3888888888888888889e-03; cp = cp * r2 + 4.1666666666666666667e-02; const double cr = 1.0 - 0.5 * r2 + r2 * r2 * cp;
    const int q = ((int)n) & 3;
    s = (q == 0) ? sr : (q == 1) ? cr : (q == 2) ? -sr : -cr;
    c = (q == 0) ? cr : (q == 1) ? -sr : (q == 2) ? -cr : sr;
}

__device__ __forceinline__ void transpose_item(const float* W, int K, int N, bf16* WT, int k0, int n0, int dst_row0, LAS float* scr, int lane) {
#pragma unroll 8
    for (int i = 0; i < 32; ++i) { const int kk = 2 * i + (lane >> 5); scr[kk * 33 + (lane & 31)] = W[(size_t)(k0 + kk) * N + n0 + (lane & 31)]; }
    LDS_WAIT(); asm volatile("" ::: "memory");
    const int c = lane & 7;
#pragma unroll
    for (int j = 0; j < 4; ++j) { const int n = (lane >> 3) + 8 * j; const LAS float* s = scr + (8 * c) * 33 + n;
        v4u o; o.x = pk2(s[0 * 33], s[1 * 33]); o.y = pk2(s[2 * 33], s[3 * 33]); o.z = pk2(s[4 * 33], s[5 * 33]); o.w = pk2(s[6 * 33], s[7 * 33]);
        *(GAS v4u*)(WT + (size_t)(dst_row0 + n) * K + k0 + 8 * c) = o; }
    LDS_WAIT(); asm volatile("" ::: "memory");
}
__device__ __forceinline__ float wave_sum(float v) {
#pragma unroll
    for (int o = 1; o < 64; o <<= 1) v += __shfl_xor(v, o);
    return v;
}
template <int W, int R>
__device__ __forceinline__ void copy_shift(const float* src, float* dst, int gtid, int gthreads) {
    constexpr int VPB = (W - 1) * R / 4, BPITCH = W * R / 4, TOTAL = NSAMP * VPB;
    const f32x4* s4 = (const f32x4*)src; f32x4* d4 = (f32x4*)dst;
    int id = gtid;
    for (; id + 3 * gthreads < TOTAL; id += 4 * gthreads) {
        f32x4 v[4]; int o[4];
#pragma unroll
        for (int k = 0; k < 4; ++k) { const int x = id + k * gthreads; const int b = x / VPB, w = x - b * VPB; o[k] = b * BPITCH + w; v[k] = __builtin_nontemporal_load(s4 + o[k] + R / 4); }
#pragma unroll
        for (int k = 0; k < 4; ++k) __builtin_nontemporal_store(v[k], d4 + o[k]);
    }
    for (; id < TOTAL; id += gthreads) { const int b = id / VPB, w = id - b * VPB; d4[b * BPITCH + w] = s4[b * BPITCH + w + R / 4]; }
}

struct Args { const float* in[16]; float* out; unsigned char* ws; int ph_lo, ph_hi; };

__global__ void __launch_bounds__(NWAVES * 64, 2) fwd(Args args) {
    extern __shared__ __attribute__((aligned(16))) unsigned char lds_raw[];
    LAS unsigned char* lds = (LAS unsigned char*)lds_raw;
    volatile LAS unsigned* MISC = (volatile LAS unsigned*)(lds + MISC_OFF);
    const int tid = threadIdx.x, lane = tid & 63, wave = __builtin_amdgcn_readfirstlane(tid >> 6);
    const int G = gridDim.x, bid = blockIdx.x;
    unsigned char* ws = args.ws;
    gu32* ctl = (gu32*)(ws + WS_CTL);
    const float* x_prompt = args.in[0]; const float* x_sample = args.in[1];
    const float* cache_a = args.in[2]; const float* cache_b1 = args.in[3]; const float* cache_b2 = args.in[4]; const float* cache_b3 = args.in[5];
    const float* norm1_g = args.in[6]; const float* w_in = args.in[7]; const float* sinks = args.in[8]; const float* w_pa = args.in[9]; const float* w_pb = args.in[10];
    const float* w_o = args.in[11]; const float* norm2_g = args.in[12]; const float* w_gu = args.in[13]; const float* w_down = args.in[14]; const float* final_g = args.in[15];
    float* out = args.out;
    float* cosT = (float*)(ws + WS_ROPE); float* sinT = (float*)(ws + WS_ROPE + 512 * 1024);
    bf16* Win_t = (bf16*)(ws + WS_WIN); bf16* Wgu_t = (bf16*)(ws + WS_WGU); bf16* Wdn_t = (bf16*)(ws + WS_WDN); bf16* Wpa_t = (bf16*)(ws + WS_WPA); bf16* Wpb_t = (bf16*)(ws + WS_WPB); bf16* Wo_t = (bf16*)(ws + WS_WO);
    float* LSE = (float*)(ws + WS_LSE);
    bf16* XN = (bf16*)(ws + WS_XN); bf16* Z = (bf16*)(ws + WS_Z); bf16* OA = (bf16*)(ws + WS_OA); bf16* OB = (bf16*)(ws + WS_OB); bf16* OG = (bf16*)(ws + WS_OG);
    float* TMP = (float*)(ws + WS_TMP); bf16* MB = (bf16*)(ws + WS_MB); float* X1 = (float*)(ws + WS_X1); bf16* XB2 = (bf16*)(ws + WS_XB2); bf16* HH = (bf16*)(ws + WS_HH);
    float* RSQ2 = (float*)(ws + WS_CTL) + CW_RSQ2; float* RSQ3 = (float*)(ws + WS_CTL) + CW_RSQ3;

    for (int u = tid; u < (LDS_BYTES - RING_BYTES) / 4; u += NWAVES * 64) ((LAS unsigned*)(lds + RING_BYTES))[u] = 0u;
    __syncthreads();
    const int lo = args.ph_lo, hi = args.ph_hi;
    XcdBarrier bar; bar.bar = (unsigned*)(ctl + CW_BAR); bar.x = 0; bar.st = nullptr;
    if (hi - lo > 1) bar = xcd_barrier_post((unsigned*)(ctl + CW_BAR), MISC + 8);
#define IN(k) (lo <= (k) && (k) < hi)
#define SEAM(k) do { if (IN(k) && IN((k) + 1)) xcd_barrier(bar); } while (0)
    const int gw = bid * NWAVES + wave, NGW = G * NWAVES;

    if (IN(0)) {
        LAS float* scr = (LAS float*)(lds + wave * 16384);
        constexpr int I_IN = 16 * 176, I_GU = 16 * 176, I_DN = 44 * 32, I_PA = 16 * 32, I_PB = 4 * 32, I_O = 16 * 32;
        constexpr int NITEMS = I_IN + I_GU + I_DN + I_PA + I_PB + I_O;
        for (int it = gw; it < NITEMS; it += NGW) {
            int r = it;
            if (r < I_IN) { const int kb = r / 176, nb = r % 176, n0 = 32 * nb, pn = n0 >> 8, within = n0 & 255, wc = within >> 6, bj = (within >> 5) & 1;
                transpose_item(w_in, DM, NIN, Win_t, 64 * kb, n0, 256 * pn + 128 * bj + 32 * wc, scr, lane); continue; } r -= I_IN;
            if (r < I_GU) { const int kb = r / 176, nb = r % 176, n0 = 32 * nb; const int isu = n0 >= DFF, f0 = isu ? n0 - DFF : n0;
                transpose_item(w_gu, DM, NIN, Wgu_t, 64 * kb, n0, 256 * (f0 >> 7) + 128 * isu + (f0 & 127), scr, lane); continue; } r -= I_GU;
            if (r < I_DN) { const int kb = r / 32, nb = r % 32; transpose_item(w_down, DFF, DM, Wdn_t, 64 * kb, 32 * nb, 32 * nb, scr, lane); continue; } r -= I_DN;
            if (r < I_PA) { const int kb = r / 32, nb = r % 32; transpose_item(w_pa, DM, DM, Wpa_t, 64 * kb, 32 * nb, 32 * nb, scr, lane); continue; } r -= I_PA;
            if (r < I_PB) { const int kb = r / 32, nb = r % 32; transpose_item(w_pb, 256, DM, Wpb_t, 64 * kb, 32 * nb, 32 * nb, scr, lane); continue; } r -= I_PB;
            { const int kb = r / 32, nb = r % 32; transpose_item(w_o, DM, DM, Wo_t, 64 * kb, 32 * nb, 32 * nb, scr, lane); }
        }
        for (int idx = bid * 512 + tid; idx < 2049 * 32; idx += G * 512) { const int p = idx >> 5, i = idx & 31; const double ang = (double)(p < 2048 ? p : PAST) * INVF[i]; double s, c; sincos_d(ang, s, c); cosT[idx] = (float)c; sinT[idx] = (float)s; }
        { f32x4 gv[4];
#pragma unroll
          for (int j = 0; j < 4; ++j) gv[j] = ((const f32x4*)norm1_g)[lane + 64 * j];
          for (int m = gw; m < MTOK; m += NGW) {
            GAS unsigned long long* o8 = (GAS unsigned long long*)(XN + (size_t)m * DM) + lane;
            if (m >= NVALID) {
#pragma unroll
                for (int j = 0; j < 4; ++j) o8[64 * j] = 0ull;
                continue; }
            const float* xrow = (m < NPROMPT) ? x_prompt + (size_t)m * DM : x_sample + (size_t)(m - NPROMPT) * DM;
            const GAS f32x4* xr = (const GAS f32x4*)xrow + lane;
            f32x4 v[4]; float s2 = 0.f;
#pragma unroll
            for (int j = 0; j < 4; ++j) { v[j] = xr[64 * j]; s2 += (v[j].x * v[j].x + v[j].y * v[j].y) + (v[j].z * v[j].z + v[j].w * v[j].w); }
            const float rstd = 1.0f / sqrtf(wave_sum(s2) * (1.f / DM) + NORM_EPS);
#pragma unroll
            for (int j = 0; j < 4; ++j) { const f32x4 t = v[j] * rstd * gv[j]; o8[64 * j] = (unsigned long long)pk2(t.x, t.y) | ((unsigned long long)pk2(t.z, t.w) << 32); }
          } }
    }
    SEAM(0);

    if (IN(1)) {
        pg8::Gemm g{XN, Win_t, MTOK, NIN, DM}; pg8::StaticOrder S; S.init(MTOK, NIN, G, bid);
        pg8::EpiIn E{Z, cosT, sinT, out};
        pg8::gemm_phase<pg8::EpiIn, pg8::StaticOrder, true, true>(lds, g, S, E);
    }
    SEAM(1);

    if (IN(2)) {
        for (int u = bid; u < 2048; u += G) {
            const int b = u >> 7, kvh = (u >> 6) & 1, pb = u & 63, p0 = pb * 32;
            __syncthreads();
            att::SlotMap sm{0, b * SEQ, 0, p0};
            att::stage_kv<3>(lds, Z, ZKA + kvh * 64, ZVA + kvh * 64, 160, sm, tid);
            __syncthreads();
            const int head = kvh * 8 + wave, tok = b * SEQ + p0 + (lane & 31);
            const int tlo = (4 - pb) > 0 ? (4 - pb) : 0;
            att::attn_wave(lds, Z + (size_t)tok * NIN + ZQA + head * 64, 0, tlo, true, sinks[head] * LOG2E, OA + (size_t)tok * DM + head * 64, nullptr, lane);
        }
        for (int u = bid; u < 1536; u += G) {
            const int u8 = u & 7, h = (u >> 3) & 3, g = (u >> 5) % 3, b = u / 96;
            const int kcol = ZKB + g * 256 + h * 64, vcol = ZVB + g * 256 + h * 64, qcol = ZQB + g * 256 + h * 64;
            __syncthreads();
            int slot_base, tlo, qtok;
            if (g == 0) { const int n0 = 256 * u8; att::SlotMap sm{0, b * SEQ, 0, n0}; att::stage_kv<6>(lds, Z, kcol, vcol, 384, sm, tid);
                slot_base = 32 * wave; tlo = (u8 == 0 && 4 - wave > 0) ? 4 - wave : 0; qtok = b * SEQ + n0 + 32 * wave + (lane & 31); }
            else if (g == 1) { const int r = u8 & 3, n0 = 256 * (u8 >> 2); att::SlotMap sm{1, b * SEQ, r, n0}; att::stage_kv<6>(lds, Z, kcol, vcol, 384, sm, tid);
                slot_base = 32 * wave; tlo = ((u8 >> 2) == 0 && 4 - wave > 0) ? 4 - wave : 0; qtok = b * SEQ + r + 4 * (n0 + 32 * wave + (lane & 31)); }
            else { att::SlotMap sm{2, b * SEQ, 2 * u8, 0}; att::stage_kv<4>(lds, Z, kcol, vcol, 256, sm, tid);
                const int res = 2 * u8 + (wave >> 2), blk = wave & 3; slot_base = 128 * (wave >> 2) + 32 * (blk - 4); tlo = 4 - blk; qtok = b * SEQ + res + 16 * (32 * blk + (lane & 31)); }
            __syncthreads();
            att::attn_wave(lds, Z + (size_t)qtok * NIN + qcol, slot_base, tlo, false, 0.f, OG + ((size_t)g * MTOK + qtok) * 256 + h * 64, LSE + ((size_t)g * MTOK + qtok) * 4 + h, lane);
        }
        __syncthreads();
        { LAS float* sc = (LAS float*)(lds + att::LSC + wave * 1024);
          for (int wt = gw; wt < NSAMP * 28; wt += NGW) {
            const int bs = wt / 28, job = wt % 28; const int tok = NPROMPT + bs; const bf16* zrow = Z + (size_t)tok * NIN;
            if (job < 16) { const int kvh = job >> 3; const float* kc = cache_a + (size_t)bs * 128 * 256 + kvh * 64;
                att::sample_wave(sc, zrow, ZQA + job * 64, ZKA + kvh * 64, ZVA + kvh * 64, kc, kc + 128, 128, 1, 256, true, sinks[job] * LOG2E, OA + (size_t)tok * DM + job * 64, nullptr, lane); }
            else { const int g = (job - 16) >> 2, h = (job - 16) & 3; const int W = 128 << (2 * g), d = 1 << (2 * g);
                const float* cb = (g == 0) ? cache_b1 : (g == 1) ? cache_b2 : cache_b3; const float* kc = cb + (size_t)bs * W * 512 + h * 64;
                att::sample_wave(sc, zrow, ZQB + g * 256 + h * 64, ZKB + g * 256 + h * 64, ZVB + g * 256 + h * 64, kc, kc + 256, W, d, 512, false, 0.f,
                                 OG + ((size_t)g * MTOK + tok) * 256 + h * 64, LSE + ((size_t)g * MTOK + tok) * 4 + h, lane); }
          } }
    }
    SEAM(2);

    if (IN(3)) {
        for (int tok = gw; tok < NVALID; tok += NGW) {
            const int h = lane >> 4, d4 = (lane & 15) * 4;
            float ls[3]; att::u32x2 ov[3];
#pragma unroll
            for (int g = 0; g < 3; ++g) { ls[g] = LSE[((size_t)g * MTOK + tok) * 4 + h]; ov[g] = *(const att::u32x2*)(OG + ((size_t)g * MTOK + tok) * 256 + h * 64 + d4); }
            const float mx = fmaxf(fmaxf(ls[0], ls[1]), ls[2]);
            float w[3], ws_ = 0.f;
#pragma unroll
            for (int g = 0; g < 3; ++g) { w[g] = __builtin_amdgcn_exp2f(ls[g] - mx); ws_ += w[g]; }
            const float inv = 1.0f / ws_; float o0 = 0.f, o1 = 0.f, o2 = 0.f, o3 = 0.f;
#pragma unroll
            for (int g = 0; g < 3; ++g) { const float a = w[g] * inv; o0 += a * pg8::bf_lo(ov[g].x); o1 += a * pg8::bf_hi(ov[g].x); o2 += a * pg8::bf_lo(ov[g].y); o3 += a * pg8::bf_hi(ov[g].y); }
            att::u32x2 r; r.x = pk2(o0, o1); r.y = pk2(o2, o3);
            *(att::u32x2*)(OB + (size_t)tok * 256 + h * 64 + d4) = r;
        }
        const int gtid = bid * 512 + tid, gthreads = G * 512;
        copy_shift<128, 256>(cache_a, out + O_SA, gtid, gthreads);
        copy_shift<128, 512>(cache_b1, out + O_SB1, gtid, gthreads);
        copy_shift<512, 512>(cache_b2, out + O_SB2, gtid, gthreads);
        copy_shift<2048, 512>(cache_b3, out + O_SB3, gtid, gthreads);
    }
    SEAM(3);

    if (IN(4)) {
        pg8::Gemm g{OB, Wpb_t, MTOK, DM, 256}; pg8::StaticOrder S; S.init(MTOK, DM, G, bid);
        pg8::EpiGateB E{Z, TMP};
        pg8::gemm_phase<pg8::EpiGateB, pg8::StaticOrder, true, true>(lds, g, S, E);
    }
    SEAM(4);
    if (IN(5)) {
        pg8::Gemm g{OA, Wpa_t, MTOK, DM, DM}; pg8::StaticOrder S; S.init(MTOK, DM, G, bid);
        pg8::EpiGateA E{Z, TMP, MB};
        pg8::gemm_phase<pg8::EpiGateA, pg8::StaticOrder, true, true>(lds, g, S, E);
    }
    SEAM(5);
    if (IN(6)) {
        pg8::Gemm g{MB, Wo_t, MTOK, DM, DM}; pg8::StaticOrder S; S.init(MTOK, DM, G, bid);
        pg8::EpiWo E{x_prompt, x_sample, norm2_g, X1, XB2, RSQ2};
        pg8::gemm_phase<pg8::EpiWo, pg8::StaticOrder, true, true>(lds, g, S, E);
    }
    SEAM(6);
    if (IN(7)) {
        pg8::Gemm g{XB2, Wgu_t, MTOK, NIN, DM}; pg8::StaticOrder S; S.init(MTOK, NIN, G, bid);
        pg8::EpiGU E{RSQ2, HH};
        pg8::gemm_phase<pg8::EpiGU, pg8::StaticOrder, true, true>(lds, g, S, E);
    }
    SEAM(7);
    if (IN(8)) {
        pg8::Gemm g{HH, Wdn_t, MTOK, DM, DFF}; pg8::StaticOrder S; S.init(MTOK, DM, G, bid);
        pg8::EpiDown E{X1, final_g, out, RSQ3};
        pg8::gemm_phase<pg8::EpiDown, pg8::StaticOrder, true, true>(lds, g, S, E);
    }
    SEAM(8);
    if (IN(9)) {
        for (int m = gw; m < NVALID; m += NGW) {
            const float rs = 1.0f / sqrtf(RSQ3[m] * (1.f / DM) + NORM_EPS);
            f32x4* yr = (f32x4*)(out + O_Y + (size_t)m * DM) + lane;
#pragma unroll
            for (int j = 0; j < 4; ++j) yr[64 * j] = yr[64 * j] * rs;
        }
    }
#undef IN
#undef SEAM
}

#ifndef MK_N_LAUNCHES
#define MK_N_LAUNCHES 1
#endif
extern "C" void kernel_launch(void* const* d_in, const int* in_sizes, int n_in, void* d_out, int out_size, void* d_ws, size_t ws_size, hipStream_t stream) {
    static int grid = 0;
    if (grid == 0) {
        if (n_in != 16 || (size_t)out_size != O_END || ws_size < WS_END) { fprintf(stderr, "kernel_launch: unexpected shapes (n_in %d out %d ws %zu); nothing launched\n", n_in, out_size, ws_size); grid = -1; return; }
        int dev = 0, cus = 0, per_cu = 0;
        if (hipGetDevice(&dev) != hipSuccess || hipDeviceGetAttribute(&cus, hipDeviceAttributeMultiprocessorCount, dev) != hipSuccess) { grid = -1; return; }
        if (hipFuncSetAttribute((const void*)fwd, hipFuncAttributeMaxDynamicSharedMemorySize, LDS_BYTES) != hipSuccess) { fprintf(stderr, "kernel_launch: hipFuncSetAttribute failed\n"); grid = -1; return; }
        if (hipOccupancyMaxActiveBlocksPerMultiprocessor(&per_cu, (const void*)fwd, NWAVES * 64, LDS_BYTES) != hipSuccess || per_cu < 1) { fprintf(stderr, "kernel_launch: occupancy query says %d blocks per CU\n", per_cu); }
        (void)hipGetLastError();
        grid = cus;
    }
    if (grid < 0) return;
    (void)hipMemsetAsync((char*)d_ws + WS_CTL, 0, CTL_ZERO_BYTES, stream);
    Args a{};
    for (int i = 0; i < 16; ++i) a.in[i] = (const float*)d_in[i];
    a.out = (float*)d_out; a.ws = (unsigned char*)d_ws;
    if (MK_N_LAUNCHES == 1) { a.ph_lo = 0; a.ph_hi = NPHASE; hipLaunchKernelGGL(fwd, dim3(grid), dim3(NWAVES * 64), LDS_BYTES, stream, a); }
    else { for (int p = 0; p < NPHASE; ++p) { a.ph_lo = p; a.ph_hi = p + 1; hipLaunchKernelGGL(fwd, dim3(grid), dim3(NWAVES * 64), LDS_BYTES, stream, a); } }
}
```

```cpp
#include <hip/hip_runtime.h>
#include <cstdio>
#include <cstdint>
namespace pg8 {
#define PG8_LAS __attribute__((address_space(3)))
typedef unsigned short bf16_t;
typedef short bf16x8 __attribute__((ext_vector_type(8)));
typedef float f32x4 __attribute__((ext_vector_type(4)));
typedef unsigned u32x4 __attribute__((ext_vector_type(4)));
constexpr int BM = 256, BK = 64, HALF = 128, HTB = HALF * BK * 2  , STAGE_BYTES = 8 * HTB, NXCD = 8, WGM = 8;

__host__ __device__ __forceinline__ int lds_byte(int r, int c) { const int st = (r >> 4) * 2 + (c >> 5), rr = r & 15, cc = c & 31, ob = rr * 64 + cc * 2; return st * 1024 + (ob ^ (((ob >> 9) & 1) << 5)); }
__host__ __device__ __forceinline__ void stage_rc(int b, int& R, int& C) { const int st = b / 1024, sb = b % 1024, swz = sb ^ (((sb >> 9) & 1) << 5); R = (st >> 1) * 16 + swz / 64; C = (st & 1) * 32 + (swz % 64) / 2; }
__host__ __device__ __forceinline__ int perm32(int rho) { const int n = rho >> 4, i = rho & 15; return 8 * (i >> 2) + 4 * n + (i & 3); }

struct Unit { int pm, pn; };
struct Gemm { const bf16_t* A; const bf16_t* Bt; int M, N, K; };

struct StaticOrder {
    int nM, nN, nwg, G, c;
    __host__ __device__ void init(int M, int N, int G_, int c_) { nM = M / BM; nN = N / BM; nwg = nM * nN; G = G_; c = c_; }
    __host__ __device__ bool next(int i, Unit& u) const {
        const long L = (long)i * G + c; if (L >= nwg) return false;
        int wgid = (int)L; { const int q = nwg / NXCD, r = nwg % NXCD, xcd = wgid % NXCD, off = wgid / NXCD; wgid = (xcd < r ? xcd * (q + 1) : r * (q + 1) + (xcd - r) * q) + off; }
        const int nig = WGM * nN, gid = wgid / nig, fm = gid * WGM, gsz = (nM - fm) < WGM ? (nM - fm) : WGM;
        u.pm = fm + ((wgid % nig) % gsz); u.pn = (wgid % nig) / gsz; return true;
    }
    __device__ __forceinline__ void a_ready(const Unit&) const {}
    __device__ __forceinline__ void done(const Unit&) const {}
};

__device__ __forceinline__ unsigned cvt_pk_bf16(float lo, float hi) { unsigned r; asm volatile("v_cvt_pk_bf16_f32 %0, %1, %2" : "=v"(r) : "v"(lo), "v"(hi)); return r; }
typedef float f32x2 __attribute__((ext_vector_type(2)));
constexpr int CP_NL = 16, CP_CH = 512 * CP_NL;
constexpr int CP_NS = 128;
template <int W, int R> struct CpShape { static constexpr int VPB = (W - 1) * R / 4, BP = W * R / 4, NV = CP_NS * VPB, NCH = (NV + CP_CH - 1) / CP_CH; };
typedef CpShape<128, 256> CpA; typedef CpShape<128, 512> CpB1; typedef CpShape<512, 512> CpB2; typedef CpShape<2048, 512> CpB3;
constexpr int CP_C0 = CpA::NCH, CP_C1 = CP_C0 + CpB1::NCH, CP_C2 = CP_C1 + CpB2::NCH, CP_NCHUNK = CP_C2 + CpB3::NCH;
template <class SH, int R> __device__ __forceinline__ void cp_ld(const float* src, int lc, int tid, f32x4 (&d)[CP_NL]) {
    const f32x4* s4 = (const f32x4*)src + R / 4;
#pragma unroll
    for (int k = 0; k < CP_NL; ++k) { const int v = lc * CP_CH + k * 512 + tid; if (v < SH::NV) { const int b = v / SH::VPB, w = v - b * SH::VPB; d[k] = __builtin_nontemporal_load(s4 + b * SH::BP + w); } }
}
template <class SH> __device__ __forceinline__ void cp_st(float* dst, int lc, int tid, const f32x4 (&d)[CP_NL]) {
    f32x4* d4 = (f32x4*)dst;
#pragma unroll
    for (int k = 0; k < CP_NL; ++k) { const int v = lc * CP_CH + k * 512 + tid; if (v < SH::NV) { const int b = v / SH::VPB, w = v - b * SH::VPB; __builtin_nontemporal_store(d[k], d4 + b * SH::BP + w); } }
}
struct CopyJob {
    const float* s0; const float* s1; const float* s2; const float* s3; float* d0; float* d1; float* d2; float* d3;
    __device__ __forceinline__ void load(int c, int tid, f32x4 (&d)[CP_NL]) const {
        if (c < CP_C0) cp_ld<CpA, 256>(s0, c, tid, d); else if (c < CP_C1) cp_ld<CpB1, 512>(s1, c - CP_C0, tid, d); else if (c < CP_C2) cp_ld<CpB2, 512>(s2, c - CP_C1, tid, d); else if (c < CP_NCHUNK) cp_ld<CpB3, 512>(s3, c - CP_C2, tid, d);
    }
    __device__ __forceinline__ void store(int c, int tid, const f32x4 (&d)[CP_NL]) const {
        if (c < CP_C0) cp_st<CpA>(d0, c, tid, d); else if (c < CP_C1) cp_st<CpB1>(d1, c - CP_C0, tid, d); else if (c < CP_C2) cp_st<CpB2>(d2, c - CP_C1, tid, d); else if (c < CP_NCHUNK) cp_st<CpB3>(d3, c - CP_C2, tid, d);
    }
};
template <class Epi, class Sched, bool ALIGN_EPI = false, bool SP2 = false>
__device__ __forceinline__ void gemm_phase(PG8_LAS unsigned char* lds, const Gemm g, const Sched& S, const Epi& E) {
    int tid_ = threadIdx.x; asm volatile("" : "+v"(tid_));
    const int tid = tid_, wid = __builtin_amdgcn_readfirstlane(tid >> 6), lane = tid & 63, wr = wid >> 2, wc = wid & 3, fr = lane & 15, fq = lane >> 4;
    const int K = g.K, nt = K / BK;
    unsigned voffA[2], voffB[2];
#pragma unroll
    for (int i = 0; i < 2; ++i) { int R, C; stage_rc(tid * 16 + i * 8192, R, C); const int Rb = Epi::PERM ? ((R & ~31) + perm32(R & 31)) : R;
        voffA[i] = (unsigned)(R * K + C) * 2u; voffB[i] = (unsigned)(Rb * K + C) * 2u; }
    const size_t kstep = (size_t)(BK * 2);
    const size_t hstep = (size_t)HALF * K * 2;
    const size_t tstep = 2 * hstep;
    const unsigned ldsw = (unsigned)wid * 1024u;
    const int aoff = lds_byte(wr * 64 + fr, fq * 8), boff = lds_byte(wc * 32 + fr, fq * 8);
#define PG8_SA(b, h) (((b) * 2 + (h)) * HTB)
#define PG8_SB(b, h) ((4 + (b) * 2 + (h)) * HTB)
#define PG8_STAGE(bufoff, gbase, voff) do { _Pragma("unroll") for (int _i = 0; _i < 2; ++_i) \
        __builtin_amdgcn_global_load_lds((const unsigned*)((const char*)(gbase) + (voff)[_i]), (PG8_LAS unsigned*)(lds + (bufoff) + ldsw + _i * 8192), 16, 0, 0); } while (0)
#define PG8_LDA(dst, b, h) do { _Pragma("unroll") for (int m = 0; m < 4; ++m) _Pragma("unroll") for (int k = 0; k < 2; ++k) dst[m][k] = *(const PG8_LAS bf16x8*)(lds + PG8_SA(b, h) + aoff + m * 2048 + k * 1024); } while (0)
#define PG8_LDB(dst, b, h) do { _Pragma("unroll") for (int n = 0; n < 2; ++n) _Pragma("unroll") for (int k = 0; k < 2; ++k) dst[n][k] = *(const PG8_LAS bf16x8*)(lds + PG8_SB(b, h) + boff + n * 2048 + k * 1024); } while (0)
#define PG8_MMA(ai, bj, At, Bt) do { __builtin_amdgcn_s_setprio(1); _Pragma("unroll") for (int m = 0; m < 4; ++m) _Pragma("unroll") for (int n = 0; n < 2; ++n) _Pragma("unroll") for (int k = 0; k < 2; ++k) \
        acc[ai][bj][m][n] = __builtin_amdgcn_mfma_f32_16x16x32_bf16(Bt[n][k], At[m][k], acc[ai][bj][m][n], 0, 0, 0); __builtin_amdgcn_s_setprio(0); } while (0)
#define PG8_WAIT_V(n) asm volatile("s_waitcnt vmcnt(" #n ")" ::: "memory")
#define PG8_WAIT_L(n) asm volatile("s_waitcnt lgkmcnt(" #n ")" ::: "memory")
#define PG8_BAR __builtin_amdgcn_s_barrier()
#define PG8_SCHED __builtin_amdgcn_sched_barrier(0)
    Unit cur, nxt; int ui = 0;
    if (!S.next(0, cur)) return;
    f32x4 acc[2][2][4][2];
#pragma unroll
    for (int a = 0; a < 2; ++a)
#pragma unroll
        for (int b = 0; b < 2; ++b)
#pragma unroll
            for (int m = 0; m < 4; ++m)
#pragma unroll
                for (int n = 0; n < 2; ++n) acc[a][b][m][n] = (f32x4){0.f, 0.f, 0.f, 0.f};
    bf16x8 At[4][2], B0[2][2], B1[2][2];
    const char* cA = (const char*)g.A + (size_t)cur.pm * tstep; const char* cB = (const char*)g.Bt + (size_t)cur.pn * tstep;
    S.a_ready(cur);
    if constexpr (SP2) {
        PG8_STAGE(PG8_SB(0, 0), cB, voffB); PG8_STAGE(PG8_SB(0, 1), cB + hstep, voffB); PG8_STAGE(PG8_SA(0, 0), cA, voffA); PG8_STAGE(PG8_SA(0, 1), cA + hstep, voffA);
        if (wr == 1) PG8_BAR;
        PG8_WAIT_V(2); PG8_BAR;
        PG8_STAGE(PG8_SB(1, 0), cB + kstep, voffB); PG8_STAGE(PG8_SA(1, 0), cA + kstep, voffA); PG8_STAGE(PG8_SB(1, 1), cB + hstep + kstep, voffB);
        PG8_WAIT_V(6); PG8_BAR;
    } else {
        PG8_STAGE(PG8_SB(0, 0), cB, voffB); PG8_STAGE(PG8_SA(0, 0), cA, voffA); PG8_STAGE(PG8_SB(0, 1), cB + hstep, voffB); PG8_STAGE(PG8_SA(0, 1), cA + hstep, voffA);
        if (wr == 1) PG8_BAR;
        PG8_WAIT_V(4); PG8_BAR;
        PG8_STAGE(PG8_SB(1, 0), cB + kstep, voffB); PG8_STAGE(PG8_SA(1, 0), cA + kstep, voffA); PG8_STAGE(PG8_SB(1, 1), cB + hstep + kstep, voffB);
        PG8_WAIT_V(6); PG8_BAR;
    }
    for (;;) {
        const bool has_next = S.next(ui + 1, nxt);
        const char* nA = has_next ? (const char*)g.A + (size_t)nxt.pm * tstep : cA; const char* nB = has_next ? (const char*)g.Bt + (size_t)nxt.pn * tstep : cB;
#pragma nounroll
        for (int t = 0; t < nt; t += 2) {
            const bool last = (t == nt - 2);
            const char* a1 = cA + (size_t)(t + 1) * kstep;
            const char* a2 = last ? nA : cA + (size_t)(t + 2) * kstep; const char* b2 = last ? nB : cB + (size_t)(t + 2) * kstep;
            const char* a3 = a2 + kstep; const char* b3 = b2 + kstep;
            if (last && has_next) S.a_ready(nxt);
            if constexpr (SP2) {
            PG8_LDB(B0, 0, 0); PG8_LDB(B1, 0, 1); PG8_SCHED; PG8_LDA(At, 0, 0); PG8_STAGE(PG8_SA(1, 1), a1 + hstep, voffA);
            PG8_WAIT_V(8); PG8_WAIT_L(0); PG8_BAR; PG8_MMA(0, 0, At, B0); PG8_MMA(0, 1, At, B1); PG8_BAR; PG8_SCHED;
            PG8_LDA(At, 0, 1); PG8_STAGE(PG8_SB(0, 0), b2, voffB); PG8_STAGE(PG8_SB(0, 1), b2 + hstep, voffB); PG8_STAGE(PG8_SA(0, 0), a2, voffA);
            PG8_WAIT_V(8); PG8_WAIT_L(0); PG8_BAR; PG8_MMA(1, 0, At, B0); PG8_MMA(1, 1, At, B1); PG8_BAR; PG8_SCHED;
            PG8_LDB(B0, 1, 0); PG8_LDB(B1, 1, 1); PG8_SCHED; PG8_LDA(At, 1, 0); PG8_STAGE(PG8_SA(0, 1), a2 + hstep, voffA);
            PG8_WAIT_V(8); PG8_WAIT_L(0); PG8_BAR; PG8_MMA(0, 0, At, B0); PG8_MMA(0, 1, At, B1); PG8_BAR; PG8_SCHED;
            PG8_LDA(At, 1, 1); PG8_STAGE(PG8_SB(1, 0), b3, voffB); PG8_STAGE(PG8_SB(1, 1), b3 + hstep, voffB); PG8_STAGE(PG8_SA(1, 0), a3, voffA);
            PG8_WAIT_V(8); PG8_WAIT_L(0); PG8_BAR; PG8_MMA(1, 0, At, B0); PG8_MMA(1, 1, At, B1); PG8_BAR; PG8_SCHED;
            } else {
            PG8_LDB(B0, 0, 0); PG8_SCHED; PG8_LDA(At, 0, 0); PG8_STAGE(PG8_SA(1, 1), a1 + hstep, voffA);
            PG8_WAIT_L(8); PG8_BAR; PG8_WAIT_L(0); PG8_MMA(0, 0, At, B0); PG8_BAR; PG8_SCHED;
            PG8_LDB(B1, 0, 1); PG8_STAGE(PG8_SB(0, 0), b2, voffB);
            PG8_BAR; PG8_WAIT_L(0); PG8_MMA(0, 1, At, B1); PG8_BAR;
            PG8_LDA(At, 0, 1); PG8_STAGE(PG8_SA(0, 0), a2, voffA);
            PG8_BAR; PG8_WAIT_L(0); PG8_MMA(1, 0, At, B0); PG8_BAR; PG8_SCHED;
            PG8_STAGE(PG8_SB(0, 1), b2 + hstep, voffB);
            PG8_WAIT_V(6); PG8_BAR; PG8_MMA(1, 1, At, B1); PG8_BAR;
            PG8_LDB(B0, 1, 0); PG8_SCHED; PG8_LDA(At, 1, 0); PG8_STAGE(PG8_SA(0, 1), a2 + hstep, voffA);
            PG8_WAIT_L(8); PG8_BAR; PG8_WAIT_L(0); PG8_MMA(0, 0, At, B0); PG8_BAR; PG8_SCHED;
            PG8_LDB(B1, 1, 1); PG8_STAGE(PG8_SB(1, 0), b3, voffB);
            PG8_BAR; PG8_WAIT_L(0); PG8_MMA(0, 1, At, B1); PG8_BAR;
            PG8_LDA(At, 1, 1); PG8_STAGE(PG8_SA(1, 0), a3, voffA);
            PG8_BAR; PG8_WAIT_L(0); PG8_MMA(1, 0, At, B0); PG8_BAR; PG8_SCHED;
            PG8_STAGE(PG8_SB(1, 1), b3 + hstep, voffB);
            PG8_WAIT_V(6); PG8_BAR; PG8_MMA(1, 1, At, B1); PG8_BAR;
            }
        }
        if constexpr (ALIGN_EPI) { if (wr == 0) PG8_BAR; }
        if constexpr (!Epi::AFTER_DRAIN) { E(acc, cur, wr, wc, fr, fq); S.done(cur); }
        if (!has_next) break;
#pragma unroll
        for (int a = 0; a < 2; ++a)
#pragma unroll
            for (int b = 0; b < 2; ++b)
#pragma unroll
                for (int m = 0; m < 4; ++m)
#pragma unroll
                    for (int n = 0; n < 2; ++n) acc[a][b][m][n] = (f32x4){0.f, 0.f, 0.f, 0.f};
        cur = nxt; cA = nA; cB = nB; ++ui;
        if constexpr (ALIGN_EPI) { if (wr == 1) PG8_BAR; }
    }
    PG8_WAIT_V(0);
    if constexpr (!ALIGN_EPI) { if (wr == 0) PG8_BAR; }
    PG8_BAR;
    if constexpr (Epi::AFTER_DRAIN) { E.fused(acc, cur, wr, wc, fr, fq, lds, wid, lane); S.done(cur); }
#undef PG8_SA
#undef PG8_SB
#undef PG8_STAGE
#undef PG8_LDA
#undef PG8_LDB
#undef PG8_MMA
#undef PG8_WAIT_V
#undef PG8_WAIT_L
#undef PG8_BAR
#undef PG8_SCHED
}
}
constexpr int DM = 1024, SEQ = 2048, NBATCH = 16, NPROMPT = NBATCH * SEQ, NSAMP = 128, PAST = 16384;
constexpr int MTOK = 129 * 256;
constexpr int NVALID = NPROMPT + NSAMP;
constexpr int NIN = 5632, DFF = 2816;
constexpr int ZQA = 0, ZKA = 1024, ZVA = 1152, ZQB = 1280, ZKB = 2048, ZVB = 2816, ZGA = 3584, ZGB = 4608;
constexpr float NORM_EPS = 1e-6f;
constexpr float LOG2E = 1.4426950408889634f;
constexpr float QSCALE = 0.125f * 1.4426950408889634f;
constexpr size_t O_Y = 0, O_PA = 33685504, O_PB1 = 34209792, O_PB2 = 35258368, O_PB3 = 39452672, O_SA = 56229888, O_SB1 = 60424192, O_SB2 = 68812800, O_SB3 = 102367232, O_END = 236584960;

namespace pg8 {
__device__ __forceinline__ float bf_lo(unsigned w) { return __uint_as_float(w << 16); }
__device__ __forceinline__ float bf_hi(unsigned w) { return __uint_as_float(w & 0xffff0000u); }
__device__ __forceinline__ float sigmoidf_(float x) { return __builtin_amdgcn_rcpf(1.0f + __builtin_amdgcn_exp2f(-x * LOG2E)); }

struct GenOrder {
    StaticOrder so; int sample, ns, c, nN;
    __device__ void init(bool smp, int N, int G_, int bid, int ns_, int c_) { sample = smp ? 1 : 0; ns = ns_; c = c_; nN = N / BM; so.init(NPROMPT, N, G_, bid); }
    __device__ bool next(int i, Unit& u) const { if (!sample) return so.next(i, u); const int pn = i * ns + c; if (pn >= nN) return false; u.pm = NPROMPT / BM; u.pn = pn; return true; }
    __device__ __forceinline__ void a_ready(const Unit&) const {}
    __device__ __forceinline__ void done(const Unit&) const {}
};
struct EpiIn {
    static constexpr bool PERM = true, AFTER_DRAIN = false;
    bf16_t* z; const float* cosT; const float* sinT; float* out;
    __device__ __forceinline__ void operator()(const f32x4 (&acc)[2][2][4][2], const Unit& u, int wr, int wc, int fr, int fq) const {
        const int pn = u.pn, pm = u.pm;
        int cls;
        if (pn < 4) cls = 0; else if (pn == 4) cls = (wc < 2) ? 1 : 2; else if (pn < 8) cls = 0; else if (pn < 11) cls = 1; else if (pn < 14) cls = 2; else cls = 3;
        const bool samp = (pm == 128);
        bool has_state = false; int rows_g = 0, HW = 0, head = 0, kv = 0; size_t obase = 0, sbase = 0;
        if (pn == 4) { has_state = true; rows_g = 128; HW = 128; head = wc & 1; kv = wc >> 1; obase = O_PA; sbase = O_SA; }
        else if (pn >= 8 && pn < 14) { const int g = (pn - 8) % 3; has_state = true; rows_g = 128 << (2 * g); HW = 256; head = wc; kv = (pn >= 11) ? 1 : 0;
            obase = (g == 0) ? O_PB1 : (g == 1) ? O_PB2 : O_PB3; sbase = (g == 0) ? O_SB1 : (g == 1) ? O_SB2 : O_SB3; }
#pragma unroll
        for (int ai = 0; ai < 2; ++ai) {
            if (samp && ai == 1) continue;
#pragma unroll
            for (int m = 0; m < 4; ++m) {
                const int r = ai * HALF + wr * 64 + m * 16 + fr; const int token = pm * BM + r;
                const int posidx = samp ? 2048 : (token & 2047);
                f32x4 lo0 = acc[ai][0][m][0], lo1 = acc[ai][0][m][1], hi0 = acc[ai][1][m][0], hi1 = acc[ai][1][m][1];
                if (cls <= 1) {
                    const f32x4 c0 = *(const f32x4*)(cosT + posidx * 32 + 8 * fq), c1 = *(const f32x4*)(cosT + posidx * 32 + 8 * fq + 4);
                    const f32x4 s0 = *(const f32x4*)(sinT + posidx * 32 + 8 * fq), s1 = *(const f32x4*)(sinT + posidx * 32 + 8 * fq + 4);
                    const f32x4 a0 = lo0 * c0 - hi0 * s0, b0 = hi0 * c0 + lo0 * s0, a1 = lo1 * c1 - hi1 * s1, b1 = hi1 * c1 + lo1 * s1;
                    lo0 = a0; hi0 = b0; lo1 = a1; hi1 = b1;
                    if (cls == 0) { lo0 = lo0 * QSCALE; lo1 = lo1 * QSCALE; hi0 = hi0 * QSCALE; hi1 = hi1 * QSCALE; }
                } else if (cls == 3) {
#pragma unroll
                    for (int e = 0; e < 4; ++e) { lo0[e] = sigmoidf_(lo0[e]); lo1[e] = sigmoidf_(lo1[e]); hi0[e] = sigmoidf_(hi0[e]); hi1[e] = sigmoidf_(hi1[e]); }
                }
                bf16_t* zp = z + (size_t)token * NIN + pn * 256 + wc * 64 + 8 * fq;
                u32x4 w; w.x = cvt_pk_bf16(lo0[0], lo0[1]); w.y = cvt_pk_bf16(lo0[2], lo0[3]); w.z = cvt_pk_bf16(lo1[0], lo1[1]); w.w = cvt_pk_bf16(lo1[2], lo1[3]);
                *(u32x4*)zp = w;
                w.x = cvt_pk_bf16(hi0[0], hi0[1]); w.y = cvt_pk_bf16(hi0[2], hi0[3]); w.z = cvt_pk_bf16(hi1[0], hi1[1]); w.w = cvt_pk_bf16(hi1[2], hi1[3]);
                *(u32x4*)(zp + 32) = w;
                if (has_state) {
                    float* dst = nullptr;
                    if (samp) { dst = out + sbase + ((size_t)(r * rows_g + rows_g - 1) * 2 + kv) * HW + head * 64; }
                    else { const int b = token >> 11, pos = token & 2047, rr = pos - (SEQ - rows_g);
                        if (rr >= 0) dst = out + obase + ((size_t)(b * rows_g + rr) * 2 + kv) * HW + head * 64; }
                    if (dst) { *(f32x4*)(dst + 8 * fq) = lo0; *(f32x4*)(dst + 8 * fq + 4) = lo1; *(f32x4*)(dst + 32 + 8 * fq) = hi0; *(f32x4*)(dst + 32 + 8 * fq + 4) = hi1; }
                }
            }
        }
    }
};

struct EpiGateB {
    static constexpr bool PERM = true, AFTER_DRAIN = false;
    const bf16_t* z; float* tmp;
    __device__ __forceinline__ void operator()(const f32x4 (&acc)[2][2][4][2], const Unit& u, int wr, int wc, int fr, int fq) const {
#pragma unroll
        for (int ai = 0; ai < 2; ++ai)
#pragma unroll
            for (int m = 0; m < 4; ++m) {
                const int token = u.pm * BM + ai * HALF + wr * 64 + m * 16 + fr;
#pragma unroll
                for (int bj = 0; bj < 2; ++bj) {
                    const int col = u.pn * BM + bj * HALF + wc * 32 + 8 * fq;
                    const u32x4 gw = *(const u32x4*)(z + (size_t)token * NIN + ZGB + col);
                    f32x4 v0 = acc[ai][bj][m][0], v1 = acc[ai][bj][m][1];
                    v0[0] *= bf_lo(gw.x); v0[1] *= bf_hi(gw.x); v0[2] *= bf_lo(gw.y); v0[3] *= bf_hi(gw.y);
                    v1[0] *= bf_lo(gw.z); v1[1] *= bf_hi(gw.z); v1[2] *= bf_lo(gw.w); v1[3] *= bf_hi(gw.w);
                    float* tp = tmp + (size_t)token * DM + col; *(f32x4*)tp = v0; *(f32x4*)(tp + 4) = v1;
                }
            }
    }
};
struct EpiGateA {
    static constexpr bool PERM = true, AFTER_DRAIN = false;
    const bf16_t* z; const float* tmp; bf16_t* mb;
    __device__ __forceinline__ void operator()(const f32x4 (&acc)[2][2][4][2], const Unit& u, int wr, int wc, int fr, int fq) const {
#pragma unroll
        for (int ai = 0; ai < 2; ++ai)
#pragma unroll
            for (int m = 0; m < 4; ++m) {
                const int token = u.pm * BM + ai * HALF + wr * 64 + m * 16 + fr;
#pragma unroll
                for (int bj = 0; bj < 2; ++bj) {
                    const int col = u.pn * BM + bj * HALF + wc * 32 + 8 * fq;
                    const u32x4 gw = *(const u32x4*)(z + (size_t)token * NIN + ZGA + col);
                    const float* tp = tmp + (size_t)token * DM + col; const f32x4 t0 = *(const f32x4*)tp, t1 = *(const f32x4*)(tp + 4);
                    f32x4 v0 = acc[ai][bj][m][0], v1 = acc[ai][bj][m][1];
                    v0[0] = v0[0] * bf_lo(gw.x) + t0[0]; v0[1] = v0[1] * bf_hi(gw.x) + t0[1]; v0[2] = v0[2] * bf_lo(gw.y) + t0[2]; v0[3] = v0[3] * bf_hi(gw.y) + t0[3];
                    v1[0] = v1[0] * bf_lo(gw.z) + t1[0]; v1[1] = v1[1] * bf_hi(gw.z) + t1[1]; v1[2] = v1[2] * bf_lo(gw.w) + t1[2]; v1[3] = v1[3] * bf_hi(gw.w) + t1[3];
                    u32x4 w; w.x = cvt_pk_bf16(v0[0], v0[1]); w.y = cvt_pk_bf16(v0[2], v0[3]); w.z = cvt_pk_bf16(v1[0], v1[1]); w.w = cvt_pk_bf16(v1[2], v1[3]);
                    *(u32x4*)(mb + (size_t)token * DM + col) = w;
                }
            }
    }
};
struct EpiWo {
    static constexpr bool PERM = true, AFTER_DRAIN = false;
    const float* xp; const float* xs; const float* g2; float* x1; bf16_t* xb2; float* rowsq;
    __device__ __forceinline__ void operator()(const f32x4 (&acc)[2][2][4][2], const Unit& u, int wr, int wc, int fr, int fq) const {
        f32x4 gv[2][2];
#pragma unroll
        for (int bj = 0; bj < 2; ++bj)
#pragma unroll
            for (int n = 0; n < 2; ++n) gv[bj][n] = *(const f32x4*)(g2 + u.pn * BM + bj * HALF + wc * 32 + 8 * fq + 4 * n);
#pragma unroll
        for (int ai = 0; ai < 2; ++ai)
#pragma unroll
            for (int m = 0; m < 4; ++m) {
                const int token = u.pm * BM + ai * HALF + wr * 64 + m * 16 + fr;
                const float* xr = (token < NPROMPT) ? xp + (size_t)token * DM : xs + (size_t)(token - NPROMPT) * DM;
                const bool valid = token < NVALID;
                float ss = 0.f;
#pragma unroll
                for (int bj = 0; bj < 2; ++bj) {
                    const int col = u.pn * BM + bj * HALF + wc * 32 + 8 * fq;
                    f32x4 a0 = (f32x4){0.f, 0.f, 0.f, 0.f}, a1 = a0;
                    if (valid) { a0 = *(const f32x4*)(xr + col); a1 = *(const f32x4*)(xr + col + 4); }
                    const f32x4 v0 = acc[ai][bj][m][0] + a0, v1 = acc[ai][bj][m][1] + a1;
                    ss += (v0[0] * v0[0] + v0[1] * v0[1]) + (v0[2] * v0[2] + v0[3] * v0[3]) + (v1[0] * v1[0] + v1[1] * v1[1]) + (v1[2] * v1[2] + v1[3] * v1[3]);
                    float* op = x1 + (size_t)token * DM + col; *(f32x4*)op = v0; *(f32x4*)(op + 4) = v1;
                    const f32x4 s0 = v0 * gv[bj][0], s1 = v1 * gv[bj][1];
                    u32x4 w; w.x = cvt_pk_bf16(s0[0], s0[1]); w.y = cvt_pk_bf16(s0[2], s0[3]); w.z = cvt_pk_bf16(s1[0], s1[1]); w.w = cvt_pk_bf16(s1[2], s1[3]);
                    *(u32x4*)(xb2 + (size_t)token * DM + col) = w;
                }
                ss += __shfl_xor(ss, 16); ss += __shfl_xor(ss, 32);
                if (fq == 0) atomicAdd(rowsq + token, ss);
            }
    }
};
struct EpiGU {
    static constexpr bool PERM = true, AFTER_DRAIN = false;
    const float* rowsq; bf16_t* hh;
    __device__ __forceinline__ void operator()(const f32x4 (&acc)[2][2][4][2], const Unit& u, int wr, int wc, int fr, int fq) const {
#pragma unroll
        for (int ai = 0; ai < 2; ++ai)
#pragma unroll
            for (int m = 0; m < 4; ++m) {
                const int token = u.pm * BM + ai * HALF + wr * 64 + m * 16 + fr;
                const float rs = __builtin_amdgcn_rsqf(rowsq[token] * (1.0f / DM) + NORM_EPS);
                f32x4 o[2];
#pragma unroll
                for (int n = 0; n < 2; ++n) {
                    const f32x4 g = acc[ai][0][m][n] * rs, uu = acc[ai][1][m][n] * rs;
#pragma unroll
                    for (int e = 0; e < 4; ++e) o[n][e] = g[e] * uu[e] * sigmoidf_(g[e]);
                }
                u32x4 w; w.x = cvt_pk_bf16(o[0][0], o[0][1]); w.y = cvt_pk_bf16(o[0][2], o[0][3]); w.z = cvt_pk_bf16(o[1][0], o[1][1]); w.w = cvt_pk_bf16(o[1][2], o[1][3]);
                *(u32x4*)(hh + (size_t)token * DFF + u.pn * HALF + wc * 32 + 8 * fq) = w;
            }
    }
};
struct EpiDown {
    static constexpr bool PERM = true, AFTER_DRAIN = false;
    const float* x1; const float* gf; float* out; float* rowsq;
    __device__ __forceinline__ void operator()(const f32x4 (&acc)[2][2][4][2], const Unit& u, int wr, int wc, int fr, int fq) const {
        f32x4 gv[2][2];
#pragma unroll
        for (int bj = 0; bj < 2; ++bj)
#pragma unroll
            for (int n = 0; n < 2; ++n) gv[bj][n] = *(const f32x4*)(gf + u.pn * BM + bj * HALF + wc * 32 + 8 * fq + 4 * n);
#pragma unroll
        for (int ai = 0; ai < 2; ++ai)
#pragma unroll
            for (int m = 0; m < 4; ++m) {
                const int token = u.pm * BM + ai * HALF + wr * 64 + m * 16 + fr;
                if (token >= NVALID) continue;
                float ss = 0.f;
#pragma unroll
                for (int bj = 0; bj < 2; ++bj) {
                    const int col = u.pn * BM + bj * HALF + wc * 32 + 8 * fq;
                    const float* xr = x1 + (size_t)token * DM + col;
                    const f32x4 v0 = acc[ai][bj][m][0] + *(const f32x4*)xr, v1 = acc[ai][bj][m][1] + *(const f32x4*)(xr + 4);
                    ss += (v0[0] * v0[0] + v0[1] * v0[1]) + (v0[2] * v0[2] + v0[3] * v0[3]) + (v1[0] * v1[0] + v1[1] * v1[1]) + (v1[2] * v1[2] + v1[3] * v1[3]);
                    float* op = out + O_Y + (size_t)token * DM + col; *(f32x4*)op = v0 * gv[bj][0]; *(f32x4*)(op + 4) = v1 * gv[bj][1];
                }
                ss += __shfl_xor(ss, 16); ss += __shfl_xor(ss, 32);
                if (fq == 0) atomicAdd(rowsq + token, ss);
            }
    }
};
constexpr int SK_P = 144, SK_B = 128 * SK_P;
template <class Epi>
__device__ __forceinline__ void skinny_gemm(PG8_LAS unsigned char* lds, const Gemm g, int pn, const Epi& E) {
    int tid_ = threadIdx.x; asm volatile("" : "+v"(tid_));
    const int tid = tid_, wid = __builtin_amdgcn_readfirstlane(tid >> 6), lane = tid & 63, wr = wid >> 2, wc = wid & 3, fr = lane & 15, fq = lane >> 4;
    const int K = g.K, ns = K / 64;
    f32x4 acc[2][2][4][2];
#pragma unroll
    for (int a = 0; a < 2; ++a)
#pragma unroll
        for (int b = 0; b < 2; ++b)
#pragma unroll
            for (int m = 0; m < 4; ++m)
#pragma unroll
                for (int n = 0; n < 2; ++n) acc[a][b][m][n] = (f32x4){0.f, 0.f, 0.f, 0.f};
    const int srow = tid >> 3, sch = tid & 7;
    const bf16_t* gA = g.A + (size_t)(NPROMPT + srow) * K + sch * 8;
    const bf16_t* gB = g.Bt + (size_t)(BM * pn + srow) * K + sch * 8;
    const int lst = srow * SK_P + sch * 16;
    u32x4 st0[6], st1[6];
#define SK_LOAD(dst, s_) do { _Pragma("unroll") for (int j = 0; j < 2; ++j) dst[j] = *(const u32x4*)(gA + (size_t)(64 * j) * K + 64 * (s_)); \
                              _Pragma("unroll") for (int j = 0; j < 4; ++j) dst[2 + j] = *(const u32x4*)(gB + (size_t)(64 * j) * K + 64 * (s_)); } while (0)
#define SK_WRITE(src) do { _Pragma("unroll") for (int j = 0; j < 2; ++j) *(PG8_LAS u32x4*)(lds + lst + 64 * j * SK_P) = src[j]; \
                           _Pragma("unroll") for (int j = 0; j < 4; ++j) *(PG8_LAS u32x4*)(lds + SK_B + lst + 64 * j * SK_P) = src[2 + j]; } while (0)
    const int aoff = (wr * 64 + fr) * SK_P + fq * 16;
    int boff[2][2];
#pragma unroll
    for (int bj = 0; bj < 2; ++bj)
#pragma unroll
        for (int n = 0; n < 2; ++n) boff[bj][n] = SK_B + (HALF * bj + 32 * wc + perm32(16 * n + fr)) * SK_P + fq * 16;
#define SK_COMPUTE() do { _Pragma("unroll") for (int kh = 0; kh < 2; ++kh) { bf16x8 a[4], b[2][2]; \
        _Pragma("unroll") for (int m = 0; m < 4; ++m) a[m] = *(const PG8_LAS bf16x8*)(lds + aoff + m * 16 * SK_P + kh * 64); \
        _Pragma("unroll") for (int bj = 0; bj < 2; ++bj) _Pragma("unroll") for (int n = 0; n < 2; ++n) b[bj][n] = *(const PG8_LAS bf16x8*)(lds + boff[bj][n] + kh * 64); \
        _Pragma("unroll") for (int bj = 0; bj < 2; ++bj) _Pragma("unroll") for (int m = 0; m < 4; ++m) _Pragma("unroll") for (int n = 0; n < 2; ++n) \
            acc[0][bj][m][n] = __builtin_amdgcn_mfma_f32_16x16x32_bf16(b[bj][n], a[m], acc[0][bj][m][n], 0, 0, 0); } } while (0)
    SK_LOAD(st0, 0); if (ns > 1) SK_LOAD(st1, 1);
    for (int s = 0; s < ns; s += 2) {
        __syncthreads(); SK_WRITE(st0); if (s + 2 < ns) SK_LOAD(st0, s + 2); __syncthreads(); SK_COMPUTE();
        __syncthreads(); SK_WRITE(st1); if (s + 3 < ns) SK_LOAD(st1, s + 3); __syncthreads(); SK_COMPUTE();
    }
    __syncthreads();
#undef SK_LOAD
#undef SK_WRITE
#undef SK_COMPUTE
    Unit u; u.pm = NPROMPT / BM; u.pn = pn;
    E(acc, u, wr, wc, fr, fq);
}
}
#define GAS __attribute__((address_space(1)))
#define LAS __attribute__((address_space(3)))
typedef unsigned short bf16;
typedef unsigned v4u __attribute__((ext_vector_type(4)));
typedef float f32x4 __attribute__((ext_vector_type(4)));
typedef short bf16x8 __attribute__((ext_vector_type(8)));
typedef GAS unsigned gu32;
typedef GAS unsigned long long gu64;
#define RLX_AGENT __ATOMIC_RELAXED, __HIP_MEMORY_SCOPE_AGENT
#define LDS_WAIT() asm volatile("s_waitcnt lgkmcnt(0)" ::: "memory")
#define VM_WAIT() asm volatile("s_waitcnt vmcnt(0)" ::: "memory")
__device__ __forceinline__ unsigned long long rt() { return __builtin_amdgcn_s_memrealtime(); }
__device__ __forceinline__ unsigned f2bf(float f) { unsigned u = __builtin_bit_cast(unsigned, f); return (u + 0x7fffu + ((u >> 16) & 1u)) >> 16; }
__device__ __forceinline__ unsigned pk2(float lo, float hi) { return f2bf(lo) | (f2bf(hi) << 16); }

#define XB_TMO      128
#define XB_XCNT(j)  (256  + 64 * (j))
#define XB_XSUB(j)  (1280 + 64 * (j))
#define XB_XGEN(j)  (2304 + 64 * (j))
#define XB_TOP      3328
#define XB_TOPGEN   3392
#define XCD_BAR_WORDS 3456
#define XB_SPIN_CAP (1u << 18)

__device__ __forceinline__ unsigned xb_ld(unsigned* p)              { return __hip_atomic_load(p, __ATOMIC_RELAXED, __HIP_MEMORY_SCOPE_AGENT); }
__device__ __forceinline__ unsigned xb_add(unsigned* p, unsigned v) { return __hip_atomic_fetch_add(p, v, __ATOMIC_RELAXED, __HIP_MEMORY_SCOPE_AGENT); }
__device__ __forceinline__ unsigned xb_xcc_id() { return (unsigned)__builtin_amdgcn_s_getreg((3 << 11) | 20) & 0xFu; }
#define XB_SPIN(cond, bar) do { unsigned _sp = 0; while (cond) { __builtin_amdgcn_s_sleep(1); \
    if ((++_sp & 255u) == 0u) { if (xb_ld(&(bar)[XB_TMO])) break; if (_sp > XB_SPIN_CAP) { atomicAdd(&(bar)[XB_TMO], 1u); break; } } } } while (0)

struct XcdBarrier {
    unsigned* bar; unsigned x;
    volatile LAS unsigned* st;
};

__device__ __forceinline__ XcdBarrier xcd_barrier_post(unsigned* bar, volatile LAS unsigned* st) {
    XcdBarrier b; b.bar = bar; b.x = xb_xcc_id(); b.st = st;
    if (threadIdx.x == 0) (void)xb_add(&bar[XB_XCNT(b.x)], 1u);
    return b;
}
__device__ __forceinline__ void xcd_barrier_complete(unsigned* bar, unsigned x, unsigned& nloc, unsigned& nx) {
    const unsigned G = gridDim.x * gridDim.y * gridDim.z;
    unsigned sum, cnt, mine, sp = 0u;
    for (;;) {
        sum = 0u; cnt = 0u; mine = 0u;
#pragma unroll
        for (unsigned j = 0; j < 16; ++j) { const unsigned c = xb_ld(&bar[XB_XCNT(j)]); sum += c; cnt += (c > 0u) ? 1u : 0u; mine = (j == x) ? c : mine; }
        if (sum == G) break;
        __builtin_amdgcn_s_sleep(1);
        if ((++sp & 255u) == 0u) { if (xb_ld(&bar[XB_TMO])) break; if (sp > XB_SPIN_CAP) { atomicAdd(&bar[XB_TMO], 1u); break; } }
    }
    nloc = mine > 0u ? mine : 1u; nx = cnt > 0u ? cnt : 1u;
}

__device__ __forceinline__ void xcd_barrier(const XcdBarrier& b) {
    asm volatile("s_waitcnt vmcnt(0)" ::: "memory");
    __syncthreads();
    if (threadIdx.x == 0) {
        unsigned* bar = b.bar;
        __builtin_amdgcn_s_waitcnt(0);
        unsigned nloc = b.st[0], nx = b.st[1];
        if (nloc == 0u) { xcd_barrier_complete(bar, b.x, nloc, nx); b.st[0] = nloc; b.st[1] = nx; }
        const unsigned old = xb_add(&bar[XB_XSUB(b.x)], 1u);
        const unsigned gen = old / nloc;
        if (old + 1u == (gen + 1u) * nloc) {
            __builtin_amdgcn_fence(__ATOMIC_RELEASE, "agent");
            asm volatile("s_waitcnt vmcnt(0)" ::: "memory");
            const unsigned og = xb_add(&bar[XB_TOP], 1u);
            const unsigned tg = og / nx;
            if (og + 1u == (tg + 1u) * nx) xb_add(&bar[XB_TOPGEN], 1u);
            else XB_SPIN(xb_ld(&bar[XB_TOPGEN]) == tg, bar);
            __builtin_amdgcn_fence(__ATOMIC_ACQUIRE, "agent");
            xb_add(&bar[XB_XGEN(b.x)], 1u);
            asm volatile("s_waitcnt vmcnt(0)" ::: "memory");
        } else {
            XB_SPIN(xb_ld(&bar[XB_XGEN(b.x)]) == gen, bar);
            __builtin_amdgcn_fence(__ATOMIC_ACQUIRE, "agent");
            asm volatile("s_waitcnt vmcnt(0)" ::: "memory");
        }
    }
    __syncthreads();
}
__device__ __forceinline__ float bf2f(bf16 v) { return __uint_as_float((unsigned)v << 16); }
namespace att {
typedef float f32x16 __attribute__((ext_vector_type(16)));
typedef short bf16x8 __attribute__((ext_vector_type(8)));
typedef short s16x4 __attribute__((ext_vector_type(4)));
typedef short v4i16_t __attribute__((ext_vector_type(4)));
typedef unsigned u32x4 __attribute__((ext_vector_type(4)));
typedef unsigned u32x2 __attribute__((ext_vector_type(2)));
constexpr int KP = 144;
constexpr int LK = 0, LV = 384 * KP;
constexpr int LSC = LV + 12 * 4096;
constexpr int ATT_LDS = LSC + 8 * 1024;
__device__ __forceinline__ int crow(int r, int hi) { return (r & 3) + 8 * (r >> 2) + 4 * hi; }
__device__ __forceinline__ s16x4 vtr(LAS const unsigned char* p) { return __builtin_bit_cast(s16x4, __builtin_amdgcn_ds_read_tr16_b64_v4i16((LAS v4i16_t*)p)); }
__device__ __forceinline__ unsigned pkbf(float lo, float hi) { typedef float f2 __attribute__((ext_vector_type(2))); typedef __bf16 b2 __attribute__((ext_vector_type(2))); f2 v = {lo, hi}; b2 b = __builtin_convertvector(v, b2); return __builtin_bit_cast(unsigned, b); }
__device__ __forceinline__ float swapmax(float m) { auto rr = __builtin_amdgcn_permlane32_swap(__float_as_uint(m), __float_as_uint(m), false, false); return fmaxf(__uint_as_float(rr[0]), __uint_as_float(rr[1])); }
__device__ __forceinline__ float swapsum(float m) { auto rr = __builtin_amdgcn_permlane32_swap(__float_as_uint(m), __float_as_uint(m), false, false); return __uint_as_float(rr[0]) + __uint_as_float(rr[1]); }

struct SlotMap { int mode, base, r, n0; };
__device__ __forceinline__ int slot_token(const SlotMap& sm, int s) {
    if (sm.mode == 2) return sm.base + sm.r + (s >> 7) + 16 * (s & 127);
    const int n = sm.n0 - 128 + s; if (n < 0) return -1;
    return sm.base + sm.r + (sm.mode == 1 ? 4 * n : n);
}
template <int ITERS>
__device__ __forceinline__ void stage_kv(LAS unsigned char* lds, const bf16* z, int kcol, int vcol, int nslots, const SlotMap sm, int tid) {
    u32x4 kq[ITERS], vq[ITERS]; int ok[ITERS];
#pragma unroll
    for (int it = 0; it < ITERS; ++it) {
        const int id = tid + it * 512; const int s = id >> 3, c = id & 7; ok[it] = 0;
        if (id < nslots * 8) { const int tok = slot_token(sm, s);
            if (tok >= 0) { const bf16* rp = z + (size_t)tok * NIN + c * 8; kq[it] = *(const u32x4*)(rp + kcol); vq[it] = *(const u32x4*)(rp + vcol); ok[it] = 1; } }
    }
#pragma unroll
    for (int it = 0; it < ITERS; ++it) {
        const int id = tid + it * 512; const int s = id >> 3, c = id & 7;
        if (ok[it]) { *(LAS u32x4*)(lds + LK + s * KP + c * 16) = kq[it];
            *(LAS u32x4*)(lds + LV + (s >> 5) * 4096 + (c >> 2) * 2048 + (s & 31) * 64 + (c & 3) * 16) = vq[it]; }
    }
}
__device__ __forceinline__ void attn_wave(LAS unsigned char* lds, const bf16* qrow, int slot_base, int t_lo, bool has_sink, float sink2, bf16* orow, float* lsep, int lane) {
    const int i = lane & 31, h = lane >> 5;
    bf16x8 qr[4];
#pragma unroll
    for (int ks = 0; ks < 4; ++ks) qr[ks] = *(const bf16x8*)(qrow + 16 * ks + 8 * h);
    f32x16 st[5];
    const float NEG = -INFINITY;
#pragma unroll
    for (int t = 0; t < 5; ++t) {
        if (t >= t_lo) {
            LAS const unsigned char* kp = lds + LK + (slot_base + 32 * t + i) * KP + h * 16;
            f32x16 acc = {};
#pragma unroll
            for (int ks = 0; ks < 4; ++ks) { const bf16x8 kf = *(LAS const bf16x8*)(kp + ks * 32); acc = __builtin_amdgcn_mfma_f32_32x32x16_bf16(kf, qr[ks], acc, 0, 0, 0); }
            st[t] = acc;
        } else {
#pragma unroll
            for (int r = 0; r < 16; ++r) st[t][r] = NEG;
        }
    }
#pragma unroll
    for (int r = 0; r < 16; ++r) { const int j = crow(r, h); if (j < i) st[0][r] = NEG; if (j > i) st[4][r] = NEG; }
    float m = NEG;
#pragma unroll
    for (int t = 0; t < 5; ++t)
#pragma unroll
        for (int r = 0; r < 16; ++r) m = fmaxf(m, st[t][r]);
    m = swapmax(m);
    if (has_sink) m = fmaxf(m, sink2);
    float l = 0.f;
#pragma unroll
    for (int t = 0; t < 5; ++t)
#pragma unroll
        for (int r = 0; r < 16; ++r) { st[t][r] = __builtin_amdgcn_exp2f(st[t][r] - m); l += st[t][r]; }
    l = swapsum(l);
    if (has_sink) l += __builtin_amdgcn_exp2f(sink2 - m);
    f32x16 o[2]; o[0] = (f32x16){}; o[1] = (f32x16){};
    const int vlane = (4 * h + ((lane & 15) >> 2)) * 64 + ((lane >> 4) & 1) * 32 + (lane & 3) * 8;
#pragma unroll
    for (int t = 0; t < 5; ++t) {
        if (t >= t_lo) {
            LAS const unsigned char* vt = lds + LV + ((slot_base >> 5) + t) * 4096 + vlane;
#pragma unroll
            for (int s = 0; s < 2; ++s) {
                u32x4 pw; pw.x = pkbf(st[t][8 * s + 0], st[t][8 * s + 1]); pw.y = pkbf(st[t][8 * s + 2], st[t][8 * s + 3]); pw.z = pkbf(st[t][8 * s + 4], st[t][8 * s + 5]); pw.w = pkbf(st[t][8 * s + 6], st[t][8 * s + 7]);
                const bf16x8 pb = __builtin_bit_cast(bf16x8, pw);
#pragma unroll
                for (int blk = 0; blk < 2; ++blk) {
                    const s16x4 lo = vtr(vt + blk * 2048 + s * 1024), hi = vtr(vt + blk * 2048 + s * 1024 + 512);
                    const bf16x8 va = (bf16x8){lo[0], lo[1], lo[2], lo[3], hi[0], hi[1], hi[2], hi[3]};
                    o[blk] = __builtin_amdgcn_mfma_f32_32x32x16_bf16(va, pb, o[blk], 0, 0, 0);
                }
            }
        }
    }
    const float inv = 1.0f / l;
#pragma unroll
    for (int blk = 0; blk < 2; ++blk)
#pragma unroll
        for (int rg = 0; rg < 4; ++rg) {
            u32x2 w; w.x = pkbf(o[blk][4 * rg + 0] * inv, o[blk][4 * rg + 1] * inv); w.y = pkbf(o[blk][4 * rg + 2] * inv, o[blk][4 * rg + 3] * inv);
            *(u32x2*)(orow + 32 * blk + 8 * rg + 4 * h) = w;
        }
    if (lsep && h == 0) *lsep = m + __builtin_amdgcn_logf(l);
}
__device__ __forceinline__ float wsum(float v) {
#pragma unroll
    for (int o = 1; o < 64; o <<= 1) v += __shfl_xor(v, o);
    return v;
}
__device__ __forceinline__ float wmax(float v) {
#pragma unroll
    for (int o = 1; o < 64; o <<= 1) v = fmaxf(v, __shfl_xor(v, o));
    return v;
}
__device__ __forceinline__ void sample_wave(LAS float* sc, const bf16* zrow, int qcol, int kcol, int vcol, const float* kc, const float* vc, int W, int d, int rp, bool has_sink, float sink2, bf16* orow, float* lsep, int lane) {
    const float q = bf2f(zrow[qcol + lane]), kn = bf2f(zrow[kcol + lane]), vn = bf2f(zrow[vcol + lane]);
    sc[lane] = q;
    asm volatile("s_waitcnt lgkmcnt(0)" ::: "memory");
    const float s0 = wsum(q * kn);
    float sA = 0.f, sB = 0.f;
    { const float* ka = kc + (size_t)(W - d * (1 + lane)) * rp; const float* kb = kc + (size_t)(W - d * (65 + lane)) * rp;
#pragma unroll 4
      for (int c = 0; c < 16; ++c) { const f32x4 qa = *(LAS const f32x4*)(sc + 4 * c); const f32x4 a = *(const f32x4*)(ka + 4 * c), b = *(const f32x4*)(kb + 4 * c);
          sA += qa[0] * a[0] + qa[1] * a[1] + qa[2] * a[2] + qa[3] * a[3]; sB += qa[0] * b[0] + qa[1] * b[1] + qa[2] * b[2] + qa[3] * b[3]; } }
    float m = fmaxf(wmax(fmaxf(sA, sB)), s0); if (has_sink) m = fmaxf(m, sink2);
    const float pA = __builtin_amdgcn_exp2f(sA - m), pB = __builtin_amdgcn_exp2f(sB - m), p0 = __builtin_amdgcn_exp2f(s0 - m);
    float l = wsum(pA + pB) + p0; if (has_sink) l += __builtin_amdgcn_exp2f(sink2 - m);
    sc[64 + 1 + lane] = pA; sc[64 + 65 + lane] = pB;
    asm volatile("s_waitcnt lgkmcnt(0)" ::: "memory");
    float o = p0 * vn;
#pragma unroll 8
    for (int jj = 1; jj <= 128; ++jj) o += sc[64 + jj] * vc[(size_t)(W - d * jj) * rp + lane];
    orow[lane] = f2bf(o / l);
    if (lsep && lane == 0) *lsep = m + __builtin_amdgcn_logf(l);
    asm volatile("s_waitcnt lgkmcnt(0)" ::: "memory");
}
}

constexpr size_t MiB = 1u << 20;
constexpr size_t WS_CTL = 0, CTL_ZERO_BYTES = 1 * MiB;
constexpr size_t WS_ROPE = 2 * MiB;
constexpr size_t WS_WIN = 4 * MiB, WS_WGU = 16 * MiB, WS_WDN = 28 * MiB, WS_WPA = 34 * MiB, WS_WPB = 36 * MiB, WS_WO = 37 * MiB;
constexpr size_t WS_LSE = 40 * MiB;
constexpr size_t WS_XN = 64 * MiB, WS_Z = 130 * MiB, WS_OA = 486 * MiB, WS_OB = 552 * MiB, WS_OG = 570 * MiB, WS_TMP = 620 * MiB, WS_MB = 750 * MiB;
constexpr size_t WS_X1 = 816 * MiB, WS_XB2 = 946 * MiB, WS_HH = 1012 * MiB, WS_END = 1190 * MiB;
constexpr int CW_DONE = 512, CW_CPH = 1536, CW_SBAR = 1600;
constexpr int CW_BAR = 4096;
constexpr int CW_RSQ2 = 65536, CW_RSQ3 = 131072;
static_assert((CW_RSQ3 + MTOK) * 4 <= (int)CTL_ZERO_BYTES, "ctl");

constexpr int RING_BYTES = 131072, MISC_OFF = RING_BYTES + 320, LDS_BYTES = 147456;
constexpr int NWAVES = 8;
constexpr int NPHASE = 10;
#ifndef PROBE_MULT
#define PROBE_MULT 0
#define PROBE_A 2
#define PROBE_B 4
#endif
#ifndef REP2
#define REP2 1
#endif
#ifndef REP3
#define REP3 1
#endif

__device__ const double INVF[32] = {1.0, 0.7498942093324559, 0.5623413251903491, 0.4216965034285822, 0.31622776601683794, 0.23713737056616552, 0.1778279410038923, 0.1333521432163324, 0.1, 0.07498942093324558, 0.05623413251903491, 0.042169650342858224, 0.03162277660168379, 0.023713737056616554, 0.01778279410038923, 0.01333521432163324, 0.01, 0.007498942093324558, 0.005623413251903491, 0.004216965034285823, 0.0031622776601683794, 0.0023713737056616554, 0.0017782794100389228, 0.001333521432163324, 0.001, 0.0007498942093324559, 0.0005623413251903491, 0.00042169650342858224, 0.00031622776601683794, 0.00023713737056616554, 0.00017782794100389227, 0.0001333521432163324};

__device__ __forceinline__ void sincos_d(double x, double& s, double& c) {
    const double n = __builtin_rint(x * 0.63661977236758134308);
    double r = x - n * 1.57079632679489655800e+00; r = r - n * 6.12323399573676603587e-17;
    const double r2 = r * r;
    double sp = -7.6471637318198164759e-13; sp = sp * r2 + 1.6059043836821614599e-10; sp = sp * r2 - 2.5052108385441718775e-08; sp = sp * r2 + 2.7557319223985890653e-06;
    sp = sp * r2 - 1.9841269841269841270e-04; sp = sp * r2 + 8.3333333333333333333e-03; sp = sp * r2 - 1.6666666666666666667e-01; const double sr = r + r * r2 * sp;
    double cp = 4.7794773323873852974e-14; cp = cp * r2 - 1.1470745597729724714e-11; cp = cp * r2 + 2.0876756987868098979e-09; cp = cp * r2 - 2.7557319223985890653e-07;
    cp = cp * r2 + 2.4801587301587301587e-05; cp = cp * r2 - 1.3888888888888888889e-03; cp = cp * r2 + 4.1666666666666666667e-02; const double cr = 1.0 - 0.5 * r2 + r2 * r2 * cp;
    const int q = ((int)n) & 3;
    s = (q == 0) ? sr : (q == 1) ? cr : (q == 2) ? -sr : -cr;
    c = (q == 0) ? cr : (q == 1) ? -sr : (q == 2) ? -cr : sr;
}

__device__ __forceinline__ void transpose_item(const float* W, int K, int N, bf16* WT, int k0, int n0, int dst_row0, LAS float* scr, int lane) {
#pragma unroll 8
    for (int i = 0; i < 32; ++i) { const int kk = 2 * i + (lane >> 5); scr[kk * 33 + (lane & 31)] = W[(size_t)(k0 + kk) * N + n0 + (lane & 31)]; }
    LDS_WAIT(); asm volatile("" ::: "memory");
    const int c = lane & 7;
#pragma unroll
    for (int j = 0; j < 4; ++j) { const int n = (lane >> 3) + 8 * j; const LAS float* s = scr + (8 * c) * 33 + n;
        v4u o; o.x = pk2(s[0 * 33], s[1 * 33]); o.y = pk2(s[2 * 33], s[3 * 33]); o.z = pk2(s[4 * 33], s[5 * 33]); o.w = pk2(s[6 * 33], s[7 * 33]);
        *(GAS v4u*)(WT + (size_t)(dst_row0 + n) * K + k0 + 8 * c) = o; }
    LDS_WAIT(); asm volatile("" ::: "memory");
}
__device__ __forceinline__ float wave_sum(float v) {
#pragma unroll
    for (int o = 1; o < 64; o <<= 1) v += __shfl_xor(v, o);
    return v;
}
template <int W, int R>
__device__ __forceinline__ void copy_shift(const float* src, float* dst, int gtid, int gthreads) {
    constexpr int VPB = (W - 1) * R / 4, BPITCH = W * R / 4, TOTAL = NSAMP * VPB;
    const f32x4* s4 = (const f32x4*)src; f32x4* d4 = (f32x4*)dst;
    int id = gtid;
    for (; id + 3 * gthreads < TOTAL; id += 4 * gthreads) {
        f32x4 v[4]; int o[4];
#pragma unroll
        for (int k = 0; k < 4; ++k) { const int x = id + k * gthreads; const int b = x / VPB, w = x - b * VPB; o[k] = b * BPITCH + w; v[k] = __builtin_nontemporal_load(s4 + o[k] + R / 4); }
#pragma unroll
        for (int k = 0; k < 4; ++k) __builtin_nontemporal_store(v[k], d4 + o[k]);
    }
    for (; id < TOTAL; id += gthreads) { const int b = id / VPB, w = id - b * VPB; d4[b * BPITCH + w] = s4[b * BPITCH + w + R / 4]; }
}

struct Args { const float* in[16]; float* out; unsigned char* ws; int ph_lo, ph_hi; };

__global__ void __launch_bounds__(NWAVES * 64, 2) fwd(Args args) {
    extern __shared__ __attribute__((aligned(16))) unsigned char lds_raw[];
    LAS unsigned char* lds = (LAS unsigned char*)lds_raw;
    volatile LAS unsigned* MISC = (volatile LAS unsigned*)(lds + MISC_OFF);
    const int tid = threadIdx.x, lane = tid & 63, wave = __builtin_amdgcn_readfirstlane(tid >> 6);
    const int G = gridDim.x, bid = blockIdx.x;
    unsigned char* ws = args.ws;
    gu32* ctl = (gu32*)(ws + WS_CTL);
    const float* x_prompt = args.in[0]; const float* x_sample = args.in[1];
    const float* cache_a = args.in[2]; const float* cache_b1 = args.in[3]; const float* cache_b2 = args.in[4]; const float* cache_b3 = args.in[5];
    const float* norm1_g = args.in[6]; const float* w_in = args.in[7]; const float* sinks = args.in[8]; const float* w_pa = args.in[9]; const float* w_pb = args.in[10];
    const float* w_o = args.in[11]; const float* norm2_g = args.in[12]; const float* w_gu = args.in[13]; const float* w_down = args.in[14]; const float* final_g = args.in[15];
    float* out = args.out;
    float* cosT = (float*)(ws + WS_ROPE); float* sinT = (float*)(ws + WS_ROPE + 512 * 1024);
    bf16* Win_t = (bf16*)(ws + WS_WIN); bf16* Wgu_t = (bf16*)(ws + WS_WGU); bf16* Wdn_t = (bf16*)(ws + WS_WDN); bf16* Wpa_t = (bf16*)(ws + WS_WPA); bf16* Wpb_t = (bf16*)(ws + WS_WPB); bf16* Wo_t = (bf16*)(ws + WS_WO);
    float* LSE = (float*)(ws + WS_LSE);
    bf16* XN = (bf16*)(ws + WS_XN); bf16* Z = (bf16*)(ws + WS_Z); bf16* OA = (bf16*)(ws + WS_OA); bf16* OB = (bf16*)(ws + WS_OB); bf16* OG = (bf16*)(ws + WS_OG);
    float* TMP = (float*)(ws + WS_TMP); bf16* MB = (bf16*)(ws + WS_MB); float* X1 = (float*)(ws + WS_X1); bf16* XB2 = (bf16*)(ws + WS_XB2); bf16* HH = (bf16*)(ws + WS_HH);
    float* RSQ2 = (float*)(ws + WS_CTL) + CW_RSQ2; float* RSQ3 = (float*)(ws + WS_CTL) + CW_RSQ3;

    for (int u = tid; u < (LDS_BYTES - RING_BYTES) / 4; u += NWAVES * 64) ((LAS unsigned*)(lds + RING_BYTES))[u] = 0u;
    __syncthreads();
    const int lo = args.ph_lo, hi = args.ph_hi;
    XcdBarrier bar; bar.bar = (unsigned*)(ctl + CW_BAR); bar.x = 0; bar.st = nullptr;
    if (hi - lo > 1) bar = xcd_barrier_post((unsigned*)(ctl + CW_BAR), MISC + 8);
#define IN(k) (lo <= (k) && (k) < hi)
#define STAMP(i) do { if (PROBE_MULT > 0 && bid == 0 && tid == 0) { const unsigned long long t_ = rt(); MISC[32 + 2 * (i)] = (unsigned)t_; MISC[33 + 2 * (i)] = (unsigned)(t_ >> 32); } } while (0)
    STAMP(0);
#define FILL_FETCH(cond, dst) do { __syncthreads(); if (tid == 0) { unsigned c_ = 0xffffffffu; if (cond) c_ = __hip_atomic_fetch_add(ctl + CW_CPH, 1u, RLX_AGENT); MISC[16] = c_; } __syncthreads(); dst = MISC[16]; } while (0)
#define FILL_BODY(cond) do { if (tid == 0) __hip_atomic_fetch_add(ctl + CW_DONE + 64 * fill_k, 1u, RLX_AGENT); \
        unsigned c; FILL_FETCH(cond, c); \
        while (c < (unsigned)pg8::CP_NCHUNK) { f32x4 cd[pg8::CP_NL]; cpj.load((int)c, tid, cd); unsigned cn; FILL_FETCH(cond, cn); cpj.store((int)c, tid, cd); c = cn; } } while (0)
    const int gw = bid * NWAVES + wave, NGW = G * NWAVES;
    const pg8::CopyJob cpj{cache_a, cache_b1, cache_b2, cache_b3, out + O_SA, out + O_SB1, out + O_SB2, out + O_SB3};
    const int GS = G - 16; const bool roleB = bid >= GS;
#define AFTER(k) do { STAMP(2 * (k) + 1); if (IN(k)) { const int fill_k = (k); FILL_BODY(__hip_atomic_load(ctl + CW_DONE + 64 * fill_k, RLX_AGENT) < (unsigned)G); } if (IN(k) && IN((k) + 1)) xcd_barrier(bar); STAMP(2 * (k) + 2); } while (0)
#define GBAR() do { asm volatile("s_waitcnt vmcnt(0)" ::: "memory"); __syncthreads(); if (tid == 0) { const unsigned ep = MISC[17] + 1u; MISC[17] = ep; __builtin_amdgcn_fence(__ATOMIC_RELEASE, "agent"); asm volatile("s_waitcnt vmcnt(0)" ::: "memory"); __hip_atomic_fetch_add(ctl + CW_SBAR, 1u, RLX_AGENT); const unsigned want = (unsigned)(G - GS) * ep; unsigned sp = 0; while (__hip_atomic_load(ctl + CW_SBAR, RLX_AGENT) < want) { __builtin_amdgcn_s_sleep(2); if (++sp > (1u << 22)) break; } __builtin_amdgcn_fence(__ATOMIC_ACQUIRE, "agent"); asm volatile("s_waitcnt vmcnt(0)" ::: "memory"); } __syncthreads(); } while (0)
#define ORDER(smp, wide) pg8::GenOrder S; S.init(smp, (wide) ? NIN : DM, (wide) ? GS : G, bid, G - GS, bid - GS)
    if (IN(0)) {
LAS float* scr = (LAS float*)(lds + wave * 16384);
constexpr int I_IN = 16 * 176, I_GU = 16 * 176, I_DN = 44 * 32, I_PA = 16 * 32, I_PB = 4 * 32, I_O = 16 * 32;
constexpr int NITEMS = I_IN + I_GU + I_DN + I_PA + I_PB + I_O;
for (int it = gw; it < NITEMS; it += NGW) {
    int r = it;
    if (r < I_IN) { const int kb = r / 176, nb = r % 176, n0 = 32 * nb, pn = n0 >> 8, within = n0 & 255, wc = within >> 6, bj = (within >> 5) & 1;
        transpose_item(w_in, DM, NIN, Win_t, 64 * kb, n0, 256 * pn + 128 * bj + 32 * wc, scr, lane); continue; } r -= I_IN;
    if (r < I_GU) { const int kb = r / 176, nb = r % 176, n0 = 32 * nb; const int isu = n0 >= DFF, f0 = isu ? n0 - DFF : n0;
        transpose_item(w_gu, DM, NIN, Wgu_t, 64 * kb, n0, 256 * (f0 >> 7) + 128 * isu + (f0 & 127), scr, lane); continue; } r -= I_GU;
    if (r < I_DN) { const int kb = r / 32, nb = r % 32; transpose_item(w_down, DFF, DM, Wdn_t, 64 * kb, 32 * nb, 32 * nb, scr, lane); continue; } r -= I_DN;
    if (r < I_PA) { const int kb = r / 32, nb = r % 32; transpose_item(w_pa, DM, DM, Wpa_t, 64 * kb, 32 * nb, 32 * nb, scr, lane); continue; } r -= I_PA;
    if (r < I_PB) { const int kb = r / 32, nb = r % 32; transpose_item(w_pb, 256, DM, Wpb_t, 64 * kb, 32 * nb, 32 * nb, scr, lane); continue; } r -= I_PB;
    { const int kb = r / 32, nb = r % 32; transpose_item(w_o, DM, DM, Wo_t, 64 * kb, 32 * nb, 32 * nb, scr, lane); }
}
for (int idx = bid * 512 + tid; idx < 2049 * 32; idx += G * 512) { const int p = idx >> 5, i = idx & 31; const double ang = (double)(p < 2048 ? p : PAST) * INVF[i]; double s, c; sincos_d(ang, s, c); cosT[idx] = (float)c; sinT[idx] = (float)s; }
{ f32x4 gv[4];
#pragma unroll
  for (int j = 0; j < 4; ++j) gv[j] = ((const f32x4*)norm1_g)[lane + 64 * j];
  for (int m = gw; m < MTOK; m += NGW) {
    GAS unsigned long long* o8 = (GAS unsigned long long*)(XN + (size_t)m * DM) + lane;
    if (m >= NVALID) {
#pragma unroll
        for (int j = 0; j < 4; ++j) o8[64 * j] = 0ull;
        continue; }
    const float* xrow = (m < NPROMPT) ? x_prompt + (size_t)m * DM : x_sample + (size_t)(m - NPROMPT) * DM;
    const GAS f32x4* xr = (const GAS f32x4*)xrow + lane;
    f32x4 v[4]; float s2 = 0.f;
#pragma unroll
    for (int j = 0; j < 4; ++j) { v[j] = xr[64 * j]; s2 += (v[j].x * v[j].x + v[j].y * v[j].y) + (v[j].z * v[j].z + v[j].w * v[j].w); }
    const float rstd = 1.0f / sqrtf(wave_sum(s2) * (1.f / DM) + NORM_EPS);
#pragma unroll
    for (int j = 0; j < 4; ++j) { const f32x4 t = v[j] * rstd * gv[j]; o8[64 * j] = (unsigned long long)pk2(t.x, t.y) | ((unsigned long long)pk2(t.z, t.w) << 32); }
  } }
        }
    AFTER(0);
    if (IN(1)) {
        pg8::Gemm g{XN, Win_t, MTOK, NIN, DM}; pg8::EpiIn E{Z, cosT, sinT, out};
        if (!roleB) { ORDER(false, true); pg8::gemm_phase<pg8::EpiIn, pg8::GenOrder, true, true>(lds, g, S, E); }
        else for (int pn = bid - GS; pn < NIN / 256; pn += G - GS) pg8::skinny_gemm<pg8::EpiIn>(lds, g, pn, E);
    }
    AFTER(1);
    if (IN(2)) {
for (int u = bid; u < 2048; u += G) {
    const int b = u >> 7, kvh = (u >> 6) & 1, pb = u & 63, p0 = pb * 32;
    __syncthreads();
    att::SlotMap sm{0, b * SEQ, 0, p0};
    att::stage_kv<3>(lds, Z, ZKA + kvh * 64, ZVA + kvh * 64, 160, sm, tid);
    __syncthreads();
    const int head = kvh * 8 + wave, tok = b * SEQ + p0 + (lane & 31);
    const int tlo = (4 - pb) > 0 ? (4 - pb) : 0;
    att::attn_wave(lds, Z + (size_t)tok * NIN + ZQA + head * 64, 0, tlo, true, sinks[head] * LOG2E, OA + (size_t)tok * DM + head * 64, nullptr, lane);
}
for (int u = bid; u < 1536; u += G) {
    const int u8 = u & 7, h = (u >> 3) & 3, g = (u >> 5) % 3, b = u / 96;
    const int kcol = ZKB + g * 256 + h * 64, vcol = ZVB + g * 256 + h * 64, qcol = ZQB + g * 256 + h * 64;
    __syncthreads();
    int slot_base, tlo, qtok;
    if (g == 0) { const int n0 = 256 * u8; att::SlotMap sm{0, b * SEQ, 0, n0}; att::stage_kv<6>(lds, Z, kcol, vcol, 384, sm, tid);
        slot_base = 32 * wave; tlo = (u8 == 0 && 4 - wave > 0) ? 4 - wave : 0; qtok = b * SEQ + n0 + 32 * wave + (lane & 31); }
    else if (g == 1) { const int r = u8 & 3, n0 = 256 * (u8 >> 2); att::SlotMap sm{1, b * SEQ, r, n0}; att::stage_kv<6>(lds, Z, kcol, vcol, 384, sm, tid);
        slot_base = 32 * wave; tlo = ((u8 >> 2) == 0 && 4 - wave > 0) ? 4 - wave : 0; qtok = b * SEQ + r + 4 * (n0 + 32 * wave + (lane & 31)); }
    else { att::SlotMap sm{2, b * SEQ, 2 * u8, 0}; att::stage_kv<4>(lds, Z, kcol, vcol, 256, sm, tid);
        const int res = 2 * u8 + (wave >> 2), blk = wave & 3; slot_base = 128 * (wave >> 2) + 32 * (blk - 4); tlo = 4 - blk; qtok = b * SEQ + res + 16 * (32 * blk + (lane & 31)); }
    __syncthreads();
    att::attn_wave(lds, Z + (size_t)qtok * NIN + qcol, slot_base, tlo, false, 0.f, OG + ((size_t)g * MTOK + qtok) * 256 + h * 64, LSE + ((size_t)g * MTOK + qtok) * 4 + h, lane);
}
__syncthreads();
{ LAS float* sc = (LAS float*)(lds + att::LSC + wave * 1024);
  for (int wt = gw; wt < NSAMP * 28; wt += NGW) {
    const int bs = wt / 28, job = wt % 28; const int tok = NPROMPT + bs; const bf16* zrow = Z + (size_t)tok * NIN;
    if (job < 16) { const int kvh = job >> 3; const float* kc = cache_a + (size_t)bs * 128 * 256 + kvh * 64;
        att::sample_wave(sc, zrow, ZQA + job * 64, ZKA + kvh * 64, ZVA + kvh * 64, kc, kc + 128, 128, 1, 256, true, sinks[job] * LOG2E, OA + (size_t)tok * DM + job * 64, nullptr, lane); }
    else { const int g = (job - 16) >> 2, h = (job - 16) & 3; const int W = 128 << (2 * g), d = 1 << (2 * g);
        const float* cb = (g == 0) ? cache_b1 : (g == 1) ? cache_b2 : cache_b3; const float* kc = cb + (size_t)bs * W * 512 + h * 64;
        att::sample_wave(sc, zrow, ZQB + g * 256 + h * 64, ZKB + g * 256 + h * 64, ZVB + g * 256 + h * 64, kc, kc + 256, W, d, 512, false, 0.f,
                         OG + ((size_t)g * MTOK + tok) * 256 + h * 64, LSE + ((size_t)g * MTOK + tok) * 4 + h, lane); }
  } }
        }
    AFTER(2);
    if (IN(3)) {
for (int tok = gw; tok < NVALID; tok += NGW) {
    const int h = lane >> 4, d4 = (lane & 15) * 4;
    float ls[3]; att::u32x2 ov[3];
#pragma unroll
    for (int g = 0; g < 3; ++g) { ls[g] = LSE[((size_t)g * MTOK + tok) * 4 + h]; ov[g] = *(const att::u32x2*)(OG + ((size_t)g * MTOK + tok) * 256 + h * 64 + d4); }
    const float mx = fmaxf(fmaxf(ls[0], ls[1]), ls[2]);
    float w[3], ws_ = 0.f;
#pragma unroll
    for (int g = 0; g < 3; ++g) { w[g] = __builtin_amdgcn_exp2f(ls[g] - mx); ws_ += w[g]; }
    const float inv = 1.0f / ws_; float o0 = 0.f, o1 = 0.f, o2 = 0.f, o3 = 0.f;
#pragma unroll
    for (int g = 0; g < 3; ++g) { const float a = w[g] * inv; o0 += a * pg8::bf_lo(ov[g].x); o1 += a * pg8::bf_hi(ov[g].x); o2 += a * pg8::bf_lo(ov[g].y); o3 += a * pg8::bf_hi(ov[g].y); }
    att::u32x2 r; r.x = pk2(o0, o1); r.y = pk2(o2, o3);
    *(att::u32x2*)(OB + (size_t)tok * 256 + h * 64 + d4) = r;
}
        }
    AFTER(3);
    if (IN(4)) { pg8::Gemm g{OB, Wpb_t, MTOK, DM, 256}; pg8::EpiGateB E{Z, TMP}; ORDER(false, false); pg8::gemm_phase<pg8::EpiGateB, pg8::GenOrder, true, true>(lds, g, S, E); }
    AFTER(4);
    if (IN(5)) { pg8::Gemm g{OA, Wpa_t, MTOK, DM, DM}; pg8::EpiGateA E{Z, TMP, MB}; ORDER(false, false); pg8::gemm_phase<pg8::EpiGateA, pg8::GenOrder, true, true>(lds, g, S, E); }
    AFTER(5);
    if (IN(6)) { pg8::Gemm g{MB, Wo_t, MTOK, DM, DM}; pg8::EpiWo E{x_prompt, x_sample, norm2_g, X1, XB2, RSQ2}; ORDER(false, false); pg8::gemm_phase<pg8::EpiWo, pg8::GenOrder, true, true>(lds, g, S, E); }
    AFTER(6);
    if (IN(7)) {
        if (!roleB) { pg8::Gemm g{XB2, Wgu_t, MTOK, NIN, DM}; pg8::EpiGU E{RSQ2, HH}; ORDER(false, true); pg8::gemm_phase<pg8::EpiGU, pg8::GenOrder, true, true>(lds, g, S, E); }
        else {
            const int c = bid - GS, NS = G - GS;
            if (c < 4) { pg8::Gemm g{OB, Wpb_t, MTOK, DM, 256}; pg8::EpiGateB E{Z, TMP}; pg8::skinny_gemm<pg8::EpiGateB>(lds, g, c, E); }
            if (c < 4) { pg8::Gemm g{OA, Wpa_t, MTOK, DM, DM}; pg8::EpiGateA E{Z, TMP, MB}; pg8::skinny_gemm<pg8::EpiGateA>(lds, g, c, E); }
            GBAR();
            if (c < 4) { pg8::Gemm g{MB, Wo_t, MTOK, DM, DM}; pg8::EpiWo E{x_prompt, x_sample, norm2_g, X1, XB2, RSQ2}; pg8::skinny_gemm<pg8::EpiWo>(lds, g, c, E); }
            GBAR();
            { pg8::Gemm g{XB2, Wgu_t, MTOK, NIN, DM}; pg8::EpiGU E{RSQ2, HH}; for (int pn = c; pn < NIN / 256; pn += NS) pg8::skinny_gemm<pg8::EpiGU>(lds, g, pn, E); }
            GBAR();
            if (c < 4) { pg8::Gemm g{HH, Wdn_t, MTOK, DM, DFF}; pg8::EpiDown E{X1, final_g, out, RSQ3}; pg8::skinny_gemm<pg8::EpiDown>(lds, g, c, E); }
        }
    }
    AFTER(7);
    if (IN(8)) { pg8::Gemm g{HH, Wdn_t, MTOK, DM, DFF}; pg8::EpiDown E{X1, final_g, out, RSQ3}; ORDER(false, false); pg8::gemm_phase<pg8::EpiDown, pg8::GenOrder, true, true>(lds, g, S, E); }
    AFTER(8);
    STAMP(19);
    if (IN(9)) { const int fill_k = 9; FILL_BODY(true); }
    STAMP(20);
    if (IN(9)) {
for (int m = gw; m < NVALID; m += NGW) {
    const float rs = 1.0f / sqrtf(RSQ3[m] * (1.f / DM) + NORM_EPS);
    f32x4* yr = (f32x4*)(out + O_Y + (size_t)m * DM) + lane;
#pragma unroll
    for (int j = 0; j < 4; ++j) yr[64 * j] = yr[64 * j] * rs;
}
        }
    STAMP(21);
    if (PROBE_MULT > 0 && bid == 0 && tid == 0) { const unsigned long long a_ = ((unsigned long long)MISC[33 + 2 * PROBE_A] << 32) | MISC[32 + 2 * PROBE_A], b_ = ((unsigned long long)MISC[33 + 2 * PROBE_B] << 32) | MISC[32 + 2 * PROBE_B];
        const unsigned long long t0_ = rt(), ext_ = (b_ - a_) * (unsigned long long)PROBE_MULT; while (rt() - t0_ < ext_) __builtin_amdgcn_s_sleep(32); }
#undef AFTER
#undef GBAR
#undef ORDER
#undef IN
#undef FILL_BODY
#undef FILL_FETCH
}

#ifndef MK_N_LAUNCHES
#define MK_N_LAUNCHES 1
#endif
extern "C" void kernel_launch(void* const* d_in, const int* in_sizes, int n_in, void* d_out, int out_size, void* d_ws, size_t ws_size, hipStream_t stream) {
    static int grid = 0;
    if (grid == 0) {
        if (n_in != 16 || (size_t)out_size != O_END || ws_size < WS_END) { fprintf(stderr, "kernel_launch: unexpected shapes (n_in %d out %d ws %zu); nothing launched\n", n_in, out_size, ws_size); grid = -1; return; }
        int dev = 0, cus = 0, per_cu = 0;
        if (hipGetDevice(&dev) != hipSuccess || hipDeviceGetAttribute(&cus, hipDeviceAttributeMultiprocessorCount, dev) != hipSuccess) { grid = -1; return; }
        if (hipFuncSetAttribute((const void*)fwd, hipFuncAttributeMaxDynamicSharedMemorySize, LDS_BYTES) != hipSuccess) { fprintf(stderr, "kernel_launch: hipFuncSetAttribute failed\n"); grid = -1; return; }
        if (hipOccupancyMaxActiveBlocksPerMultiprocessor(&per_cu, (const void*)fwd, NWAVES * 64, LDS_BYTES) != hipSuccess || per_cu < 1) { fprintf(stderr, "kernel_launch: occupancy query says %d blocks per CU\n", per_cu); }
        (void)hipGetLastError();
        grid = cus;
    }
    if (grid < 0) return;
    (void)hipMemsetAsync((char*)d_ws + WS_CTL, 0, CTL_ZERO_BYTES, stream);
    Args a{};
    for (int i = 0; i < 16; ++i) a.in[i] = (const float*)d_in[i];
    a.out = (float*)d_out; a.ws = (unsigned char*)d_ws;
    if (MK_N_LAUNCHES == 1) { a.ph_lo = 0; a.ph_hi = NPHASE; hipLaunchKernelGGL(fwd, dim3(grid), dim3(NWAVES * 64), LDS_BYTES, stream, a); }
    else { for (int p = 0; p < NPHASE; ++p) { a.ph_lo = p; a.ph_hi = p + 1; hipLaunchKernelGGL(fwd, dim3(grid), dim3(NWAVES * 64), LDS_BYTES, stream, a); } }
}
```

```cpp
#include <hip/hip_runtime.h>
#include <cstdio>
#include <cstdint>
namespace pg8 {
#define PG8_LAS __attribute__((address_space(3)))
typedef unsigned short bf16_t;
typedef short bf16x8 __attribute__((ext_vector_type(8)));
typedef float f32x4 __attribute__((ext_vector_type(4)));
typedef unsigned u32x4 __attribute__((ext_vector_type(4)));
constexpr int BM = 256, BK = 64, HALF = 128, HTB = HALF * BK * 2  , STAGE_BYTES = 8 * HTB, NXCD = 8, WGM = 8;

__host__ __device__ __forceinline__ int lds_byte(int r, int c) { const int st = (r >> 4) * 2 + (c >> 5), rr = r & 15, cc = c & 31, ob = rr * 64 + cc * 2; return st * 1024 + (ob ^ (((ob >> 9) & 1) << 5)); }
__host__ __device__ __forceinline__ void stage_rc(int b, int& R, int& C) { const int st = b / 1024, sb = b % 1024, swz = sb ^ (((sb >> 9) & 1) << 5); R = (st >> 1) * 16 + swz / 64; C = (st & 1) * 32 + (swz % 64) / 2; }
__host__ __device__ __forceinline__ int perm32(int rho) { const int n = rho >> 4, i = rho & 15; return 8 * (i >> 2) + 4 * n + (i & 3); }

struct Unit { int pm, pn; };
struct Gemm { const bf16_t* A; const bf16_t* Bt; int M, N, K; };

struct StaticOrder {
    int nM, nN, nwg, G, c;
    __host__ __device__ void init(int M, int N, int G_, int c_) { nM = M / BM; nN = N / BM; nwg = nM * nN; G = G_; c = c_; }
    __host__ __device__ bool next(int i, Unit& u) const {
        const long L = (long)i * G + c; if (L >= nwg) return false;
        int wgid = (int)L; { const int q = nwg / NXCD, r = nwg % NXCD, xcd = wgid % NXCD, off = wgid / NXCD; wgid = (xcd < r ? xcd * (q + 1) : r * (q + 1) + (xcd - r) * q) + off; }
        const int nig = WGM * nN, gid = wgid / nig, fm = gid * WGM, gsz = (nM - fm) < WGM ? (nM - fm) : WGM;
        u.pm = fm + ((wgid % nig) % gsz); u.pn = (wgid % nig) / gsz; return true;
    }
    __device__ __forceinline__ void a_ready(const Unit&) const {}
    __device__ __forceinline__ void done(const Unit&) const {}
};

__device__ __forceinline__ unsigned cvt_pk_bf16(float lo, float hi) { unsigned r; asm volatile("v_cvt_pk_bf16_f32 %0, %1, %2" : "=v"(r) : "v"(lo), "v"(hi)); return r; }
typedef float f32x2 __attribute__((ext_vector_type(2)));
constexpr int CP_NL = 16, CP_CH = 512 * CP_NL;
constexpr int CP_NS = 128;
template <int W, int R> struct CpShape { static constexpr int VPB = (W - 1) * R / 4, BP = W * R / 4, NV = CP_NS * VPB, NCH = (NV + CP_CH - 1) / CP_CH; };
typedef CpShape<128, 256> CpA; typedef CpShape<128, 512> CpB1; typedef CpShape<512, 512> CpB2; typedef CpShape<2048, 512> CpB3;
constexpr int CP_C0 = CpA::NCH, CP_C1 = CP_C0 + CpB1::NCH, CP_C2 = CP_C1 + CpB2::NCH, CP_NCHUNK = CP_C2 + CpB3::NCH;
template <class SH, int R> __device__ __forceinline__ void cp_ld(const float* src, int lc, int tid, f32x4 (&d)[CP_NL]) {
    const f32x4* s4 = (const f32x4*)src + R / 4;
#pragma unroll
    for (int k = 0; k < CP_NL; ++k) { const int v = lc * CP_CH + k * 512 + tid; if (v < SH::NV) { const int b = v / SH::VPB, w = v - b * SH::VPB; d[k] = __builtin_nontemporal_load(s4 + b * SH::BP + w); } }
}
template <class SH> __device__ __forceinline__ void cp_st(float* dst, int lc, int tid, const f32x4 (&d)[CP_NL]) {
    f32x4* d4 = (f32x4*)dst;
#pragma unroll
    for (int k = 0; k < CP_NL; ++k) { const int v = lc * CP_CH + k * 512 + tid; if (v < SH::NV) { const int b = v / SH::VPB, w = v - b * SH::VPB; __builtin_nontemporal_store(d[k], d4 + b * SH::BP + w); } }
}
struct CopyJob {
    const float* s0; const float* s1; const float* s2; const float* s3; float* d0; float* d1; float* d2; float* d3;
    __device__ __forceinline__ void load(int c, int tid, f32x4 (&d)[CP_NL]) const {
        if (c < CP_C0) cp_ld<CpA, 256>(s0, c, tid, d); else if (c < CP_C1) cp_ld<CpB1, 512>(s1, c - CP_C0, tid, d); else if (c < CP_C2) cp_ld<CpB2, 512>(s2, c - CP_C1, tid, d); else if (c < CP_NCHUNK) cp_ld<CpB3, 512>(s3, c - CP_C2, tid, d);
    }
    __device__ __forceinline__ void store(int c, int tid, const f32x4 (&d)[CP_NL]) const {
        if (c < CP_C0) cp_st<CpA>(d0, c, tid, d); else if (c < CP_C1) cp_st<CpB1>(d1, c - CP_C0, tid, d); else if (c < CP_C2) cp_st<CpB2>(d2, c - CP_C1, tid, d); else if (c < CP_NCHUNK) cp_st<CpB3>(d3, c - CP_C2, tid, d);
    }
};
template <class Epi, class Sched, bool ALIGN_EPI = false, bool SP2 = false>
__device__ __forceinline__ void gemm_phase(PG8_LAS unsigned char* lds, const Gemm g, const Sched& S, const Epi& E) {
    int tid_ = threadIdx.x; asm volatile("" : "+v"(tid_));
    const int tid = tid_, wid = __builtin_amdgcn_readfirstlane(tid >> 6), lane = tid & 63, wr = wid >> 2, wc = wid & 3, fr = lane & 15, fq = lane >> 4;
    const int K = g.K, nt = K / BK;
    unsigned voffA[2], voffB[2];
#pragma unroll
    for (int i = 0; i < 2; ++i) { int R, C; stage_rc(tid * 16 + i * 8192, R, C); const int Rb = Epi::PERM ? ((R & ~31) + perm32(R & 31)) : R;
        voffA[i] = (unsigned)(R * K + C) * 2u; voffB[i] = (unsigned)(Rb * K + C) * 2u; }
    const size_t kstep = (size_t)(BK * 2);
    const size_t hstep = (size_t)HALF * K * 2;
    const size_t tstep = 2 * hstep;
    const unsigned ldsw = (unsigned)wid * 1024u;
    const int aoff = lds_byte(wr * 64 + fr, fq * 8), boff = lds_byte(wc * 32 + fr, fq * 8);
#define PG8_SA(b, h) (((b) * 2 + (h)) * HTB)
#define PG8_SB(b, h) ((4 + (b) * 2 + (h)) * HTB)
#define PG8_STAGE(bufoff, gbase, voff) do { _Pragma("unroll") for (int _i = 0; _i < 2; ++_i) \
        __builtin_amdgcn_global_load_lds((const unsigned*)((const char*)(gbase) + (voff)[_i]), (PG8_LAS unsigned*)(lds + (bufoff) + ldsw + _i * 8192), 16, 0, 0); } while (0)
#define PG8_LDA(dst, b, h) do { _Pragma("unroll") for (int m = 0; m < 4; ++m) _Pragma("unroll") for (int k = 0; k < 2; ++k) dst[m][k] = *(const PG8_LAS bf16x8*)(lds + PG8_SA(b, h) + aoff + m * 2048 + k * 1024); } while (0)
#define PG8_LDB(dst, b, h) do { _Pragma("unroll") for (int n = 0; n < 2; ++n) _Pragma("unroll") for (int k = 0; k < 2; ++k) dst[n][k] = *(const PG8_LAS bf16x8*)(lds + PG8_SB(b, h) + boff + n * 2048 + k * 1024); } while (0)
#define PG8_MMA(ai, bj, At, Bt) do { __builtin_amdgcn_s_setprio(1); _Pragma("unroll") for (int m = 0; m < 4; ++m) _Pragma("unroll") for (int n = 0; n < 2; ++n) _Pragma("unroll") for (int k = 0; k < 2; ++k) \
        acc[ai][bj][m][n] = __builtin_amdgcn_mfma_f32_16x16x32_bf16(Bt[n][k], At[m][k], acc[ai][bj][m][n], 0, 0, 0); __builtin_amdgcn_s_setprio(0); } while (0)
#define PG8_WAIT_V(n) asm volatile("s_waitcnt vmcnt(" #n ")" ::: "memory")
#define PG8_WAIT_L(n) asm volatile("s_waitcnt lgkmcnt(" #n ")" ::: "memory")
#define PG8_BAR __builtin_amdgcn_s_barrier()
#define PG8_SCHED __builtin_amdgcn_sched_barrier(0)
    Unit cur, nxt; int ui = 0;
    if (!S.next(0, cur)) return;
    f32x4 acc[2][2][4][2];
#pragma unroll
    for (int a = 0; a < 2; ++a)
#pragma unroll
        for (int b = 0; b < 2; ++b)
#pragma unroll
            for (int m = 0; m < 4; ++m)
#pragma unroll
                for (int n = 0; n < 2; ++n) acc[a][b][m][n] = (f32x4){0.f, 0.f, 0.f, 0.f};
    bf16x8 At[4][2], B0[2][2], B1[2][2];
    const char* cA = (const char*)g.A + (size_t)cur.pm * tstep; const char* cB = (const char*)g.Bt + (size_t)cur.pn * tstep;
    S.a_ready(cur);
    if constexpr (SP2) {
        PG8_STAGE(PG8_SB(0, 0), cB, voffB); PG8_STAGE(PG8_SB(0, 1), cB + hstep, voffB); PG8_STAGE(PG8_SA(0, 0), cA, voffA); PG8_STAGE(PG8_SA(0, 1), cA + hstep, voffA);
        if (wr == 1) PG8_BAR;
        PG8_WAIT_V(2); PG8_BAR;
        PG8_STAGE(PG8_SB(1, 0), cB + kstep, voffB); PG8_STAGE(PG8_SA(1, 0), cA + kstep, voffA); PG8_STAGE(PG8_SB(1, 1), cB + hstep + kstep, voffB);
        PG8_WAIT_V(6); PG8_BAR;
    } else {
        PG8_STAGE(PG8_SB(0, 0), cB, voffB); PG8_STAGE(PG8_SA(0, 0), cA, voffA); PG8_STAGE(PG8_SB(0, 1), cB + hstep, voffB); PG8_STAGE(PG8_SA(0, 1), cA + hstep, voffA);
        if (wr == 1) PG8_BAR;
        PG8_WAIT_V(4); PG8_BAR;
        PG8_STAGE(PG8_SB(1, 0), cB + kstep, voffB); PG8_STAGE(PG8_SA(1, 0), cA + kstep, voffA); PG8_STAGE(PG8_SB(1, 1), cB + hstep + kstep, voffB);
        PG8_WAIT_V(6); PG8_BAR;
    }
    for (;;) {
        const bool has_next = S.next(ui + 1, nxt);
        const char* nA = has_next ? (const char*)g.A + (size_t)nxt.pm * tstep : cA; const char* nB = has_next ? (const char*)g.Bt + (size_t)nxt.pn * tstep : cB;
#pragma nounroll
        for (int t = 0; t < nt; t += 2) {
            if constexpr (Epi::HOOK_T > 0) { if (t == Epi::HOOK_T) E.mid(acc, cur, wr, wc, fr, fq); }
            const bool last = (t == nt - 2);
            const char* a1 = cA + (size_t)(t + 1) * kstep;
            const char* a2 = last ? nA : cA + (size_t)(t + 2) * kstep; const char* b2 = last ? nB : cB + (size_t)(t + 2) * kstep;
            const char* a3 = a2 + kstep; const char* b3 = b2 + kstep;
            if (last && has_next) S.a_ready(nxt);
            if constexpr (SP2) {
            PG8_LDB(B0, 0, 0); PG8_LDB(B1, 0, 1); PG8_SCHED; PG8_LDA(At, 0, 0); PG8_STAGE(PG8_SA(1, 1), a1 + hstep, voffA);
            PG8_WAIT_V(8); PG8_WAIT_L(0); PG8_BAR; PG8_MMA(0, 0, At, B0); PG8_MMA(0, 1, At, B1); PG8_BAR; PG8_SCHED;
            PG8_LDA(At, 0, 1); PG8_STAGE(PG8_SB(0, 0), b2, voffB); PG8_STAGE(PG8_SB(0, 1), b2 + hstep, voffB); PG8_STAGE(PG8_SA(0, 0), a2, voffA);
            PG8_WAIT_V(8); PG8_WAIT_L(0); PG8_BAR; PG8_MMA(1, 0, At, B0); PG8_MMA(1, 1, At, B1); PG8_BAR; PG8_SCHED;
            PG8_LDB(B0, 1, 0); PG8_LDB(B1, 1, 1); PG8_SCHED; PG8_LDA(At, 1, 0); PG8_STAGE(PG8_SA(0, 1), a2 + hstep, voffA);
            PG8_WAIT_V(8); PG8_WAIT_L(0); PG8_BAR; PG8_MMA(0, 0, At, B0); PG8_MMA(0, 1, At, B1); PG8_BAR; PG8_SCHED;
            PG8_LDA(At, 1, 1); PG8_STAGE(PG8_SB(1, 0), b3, voffB); PG8_STAGE(PG8_SB(1, 1), b3 + hstep, voffB); PG8_STAGE(PG8_SA(1, 0), a3, voffA);
            PG8_WAIT_V(8); PG8_WAIT_L(0); PG8_BAR; PG8_MMA(1, 0, At, B0); PG8_MMA(1, 1, At, B1); PG8_BAR; PG8_SCHED;
            } else {
            PG8_LDB(B0, 0, 0); PG8_SCHED; PG8_LDA(At, 0, 0); PG8_STAGE(PG8_SA(1, 1), a1 + hstep, voffA);
            PG8_WAIT_L(8); PG8_BAR; PG8_WAIT_L(0); PG8_MMA(0, 0, At, B0); PG8_BAR; PG8_SCHED;
            PG8_LDB(B1, 0, 1); PG8_STAGE(PG8_SB(0, 0), b2, voffB);
            PG8_BAR; PG8_WAIT_L(0); PG8_MMA(0, 1, At, B1); PG8_BAR;
            PG8_LDA(At, 0, 1); PG8_STAGE(PG8_SA(0, 0), a2, voffA);
            PG8_BAR; PG8_WAIT_L(0); PG8_MMA(1, 0, At, B0); PG8_BAR; PG8_SCHED;
            PG8_STAGE(PG8_SB(0, 1), b2 + hstep, voffB);
            PG8_WAIT_V(6); PG8_BAR; PG8_MMA(1, 1, At, B1); PG8_BAR;
            PG8_LDB(B0, 1, 0); PG8_SCHED; PG8_LDA(At, 1, 0); PG8_STAGE(PG8_SA(0, 1), a2 + hstep, voffA);
            PG8_WAIT_L(8); PG8_BAR; PG8_WAIT_L(0); PG8_MMA(0, 0, At, B0); PG8_BAR; PG8_SCHED;
            PG8_LDB(B1, 1, 1); PG8_STAGE(PG8_SB(1, 0), b3, voffB);
            PG8_BAR; PG8_WAIT_L(0); PG8_MMA(0, 1, At, B1); PG8_BAR;
            PG8_LDA(At, 1, 1); PG8_STAGE(PG8_SA(1, 0), a3, voffA);
            PG8_BAR; PG8_WAIT_L(0); PG8_MMA(1, 0, At, B0); PG8_BAR; PG8_SCHED;
            PG8_STAGE(PG8_SB(1, 1), b3 + hstep, voffB);
            PG8_WAIT_V(6); PG8_BAR; PG8_MMA(1, 1, At, B1); PG8_BAR;
            }
        }
        if constexpr (ALIGN_EPI) { if (wr == 0) PG8_BAR; }
        if constexpr (!Epi::AFTER_DRAIN) { E(acc, cur, wr, wc, fr, fq); S.done(cur); }
        if (!has_next) break;
#pragma unroll
        for (int a = 0; a < 2; ++a)
#pragma unroll
            for (int b = 0; b < 2; ++b)
#pragma unroll
                for (int m = 0; m < 4; ++m)
#pragma unroll
                    for (int n = 0; n < 2; ++n) acc[a][b][m][n] = (f32x4){0.f, 0.f, 0.f, 0.f};
        cur = nxt; cA = nA; cB = nB; ++ui;
        if constexpr (ALIGN_EPI) { if (wr == 1) PG8_BAR; }
    }
    PG8_WAIT_V(0);
    if constexpr (!ALIGN_EPI) { if (wr == 0) PG8_BAR; }
    PG8_BAR;
    if constexpr (Epi::AFTER_DRAIN) { E.fused(acc, cur, wr, wc, fr, fq, lds, wid, lane); S.done(cur); }
#undef PG8_SA
#undef PG8_SB
#undef PG8_STAGE
#undef PG8_LDA
#undef PG8_LDB
#undef PG8_MMA
#undef PG8_WAIT_V
#undef PG8_WAIT_L
#undef PG8_BAR
#undef PG8_SCHED
}
}
constexpr int DM = 1024, SEQ = 2048, NBATCH = 16, NPROMPT = NBATCH * SEQ, NSAMP = 128, PAST = 16384;
constexpr int MTOK = 129 * 256;
constexpr int NVALID = NPROMPT + NSAMP;
constexpr int NIN = 5632, DFF = 2816;
constexpr int HQA = 0, HKA = 16, HVA = 18, HQB = 20, HKB = 32, HVB = 44, NHEADARR = 56; constexpr size_t HEADSZ = (size_t)MTOK * 64;
constexpr int ZGP = 2048, ZGA = 0, ZGB = 1024;
__device__ __forceinline__ int drow(int g, int token) { if (token >= NPROMPT || g == 0) return token; const int b = token & ~2047, pos = token & 2047; return g == 1 ? b + (pos & 3) * 512 + (pos >> 2) : b + (pos & 15) * 128 + (pos >> 4); }
constexpr int KAB = 1280;
constexpr float NORM_EPS = 1e-6f;
constexpr float LOG2E = 1.4426950408889634f;
constexpr float QSCALE = 0.125f * 1.4426950408889634f;
constexpr size_t O_Y = 0, O_PA = 33685504, O_PB1 = 34209792, O_PB2 = 35258368, O_PB3 = 39452672, O_SA = 56229888, O_SB1 = 60424192, O_SB2 = 68812800, O_SB3 = 102367232, O_END = 236584960;

namespace pg8 {
__device__ __forceinline__ float bf_lo(unsigned w) { return __uint_as_float(w << 16); }
__device__ __forceinline__ float bf_hi(unsigned w) { return __uint_as_float(w & 0xffff0000u); }
__device__ __forceinline__ float sigmoidf_(float x) { return __builtin_amdgcn_rcpf(1.0f + __builtin_amdgcn_exp2f(-x * LOG2E)); }

struct GenOrder {
    StaticOrder so; int sample, ns, c, nN;
    __device__ void init(bool smp, int N, int G_, int bid, int ns_, int c_) { sample = smp ? 1 : 0; ns = ns_; c = c_; nN = N / BM; so.init(NPROMPT, N, G_, bid); }
    __device__ bool next(int i, Unit& u) const { if (!sample) return so.next(i, u); const int pn = i * ns + c; if (pn >= nN) return false; u.pm = NPROMPT / BM; u.pn = pn; return true; }
    __device__ __forceinline__ void a_ready(const Unit&) const {}
    __device__ __forceinline__ void done(const Unit&) const {}
};
struct EpiIn {
    static constexpr bool PERM = true, AFTER_DRAIN = false; static constexpr int HOOK_T = 0;
    bf16_t* qkv; bf16_t* zg; const float* cosT; const float* sinT; float* out;
    __device__ __forceinline__ void operator()(const f32x4 (&acc)[2][2][4][2], const Unit& u, int wr, int wc, int fr, int fq) const {
        const int pn = u.pn, pm = u.pm;
        int cls;
        if (pn < 4) cls = 0; else if (pn == 4) cls = (wc < 2) ? 1 : 2; else if (pn < 8) cls = 0; else if (pn < 11) cls = 1; else if (pn < 14) cls = 2; else cls = 3;
        const bool samp = (pm == 128);
        bool has_state = false; int rows_g = 0, HW = 0, head = 0, kv = 0; size_t obase = 0, sbase = 0;
        if (pn == 4) { has_state = true; rows_g = 128; HW = 128; head = wc & 1; kv = wc >> 1; obase = O_PA; sbase = O_SA; }
        else if (pn >= 8 && pn < 14) { const int g = (pn - 8) % 3; has_state = true; rows_g = 128 << (2 * g); HW = 256; head = wc; kv = (pn >= 11) ? 1 : 0;
            obase = (g == 0) ? O_PB1 : (g == 1) ? O_PB2 : O_PB3; sbase = (g == 0) ? O_SB1 : (g == 1) ? O_SB2 : O_SB3; }
#pragma unroll
        for (int ai = 0; ai < 2; ++ai) {
            if (samp && ai == 1) continue;
#pragma unroll
            for (int m = 0; m < 4; ++m) {
                const int r = ai * HALF + wr * 64 + m * 16 + fr; const int token = pm * BM + r;
                const int posidx = samp ? 2048 : (token & 2047);
                f32x4 lo0 = acc[ai][0][m][0], lo1 = acc[ai][0][m][1], hi0 = acc[ai][1][m][0], hi1 = acc[ai][1][m][1];
                if (cls <= 1) {
                    const f32x4 c0 = *(const f32x4*)(cosT + posidx * 32 + 8 * fq), c1 = *(const f32x4*)(cosT + posidx * 32 + 8 * fq + 4);
                    const f32x4 s0 = *(const f32x4*)(sinT + posidx * 32 + 8 * fq), s1 = *(const f32x4*)(sinT + posidx * 32 + 8 * fq + 4);
                    const f32x4 a0 = lo0 * c0 - hi0 * s0, b0 = hi0 * c0 + lo0 * s0, a1 = lo1 * c1 - hi1 * s1, b1 = hi1 * c1 + lo1 * s1;
                    lo0 = a0; hi0 = b0; lo1 = a1; hi1 = b1;
                    if (cls == 0) { lo0 = lo0 * QSCALE; lo1 = lo1 * QSCALE; hi0 = hi0 * QSCALE; hi1 = hi1 * QSCALE; }
                } else if (cls == 3) {
#pragma unroll
                    for (int e = 0; e < 4; ++e) { lo0[e] = sigmoidf_(lo0[e]); lo1[e] = sigmoidf_(lo1[e]); hi0[e] = sigmoidf_(hi0[e]); hi1[e] = sigmoidf_(hi1[e]); }
                }
                bf16_t* zp;
                if (pn >= 14) zp = zg + (size_t)token * ZGP + (pn - 14) * 256 + wc * 64 + 8 * fq;
                else { int harr, g = 0; if (pn < 4) harr = HQA + 4 * pn + wc; else if (pn == 4) harr = HKA + wc; else if (pn < 8) { g = pn - 5; harr = HQB + 4 * g + wc; } else if (pn < 11) { g = pn - 8; harr = HKB + 4 * g + wc; } else { g = pn - 11; harr = HVB + 4 * g + wc; }
                    zp = qkv + (size_t)harr * HEADSZ + (size_t)drow(g, token) * 64 + 8 * fq; }
                u32x4 w; w.x = cvt_pk_bf16(lo0[0], lo0[1]); w.y = cvt_pk_bf16(lo0[2], lo0[3]); w.z = cvt_pk_bf16(lo1[0], lo1[1]); w.w = cvt_pk_bf16(lo1[2], lo1[3]);
                *(u32x4*)zp = w;
                w.x = cvt_pk_bf16(hi0[0], hi0[1]); w.y = cvt_pk_bf16(hi0[2], hi0[3]); w.z = cvt_pk_bf16(hi1[0], hi1[1]); w.w = cvt_pk_bf16(hi1[2], hi1[3]);
                *(u32x4*)(zp + 32) = w;
                if (has_state) {
                    float* dst = nullptr;
                    if (samp) { dst = out + sbase + ((size_t)(r * rows_g + rows_g - 1) * 2 + kv) * HW + head * 64; }
                    else { const int b = token >> 11, pos = token & 2047, rr = pos - (SEQ - rows_g);
                        if (rr >= 0) dst = out + obase + ((size_t)(b * rows_g + rr) * 2 + kv) * HW + head * 64; }
                    if (dst) { *(f32x4*)(dst + 8 * fq) = lo0; *(f32x4*)(dst + 8 * fq + 4) = lo1; *(f32x4*)(dst + 32 + 8 * fq) = hi0; *(f32x4*)(dst + 32 + 8 * fq + 4) = hi1; }
                }
            }
        }
    }
};

struct EpiGate {
    static constexpr bool PERM = true, AFTER_DRAIN = false; static constexpr int HOOK_T = 16;
    const bf16_t* z; bf16_t* mb;
    __device__ __forceinline__ void mid(f32x4 (&acc)[2][2][4][2], const Unit& u, int wr, int wc, int fr, int fq) const {
#pragma unroll
        for (int ai = 0; ai < 2; ++ai)
#pragma unroll
            for (int m = 0; m < 4; ++m) {
                const int token = u.pm * BM + ai * HALF + wr * 64 + m * 16 + fr;
#pragma unroll
                for (int bj = 0; bj < 2; ++bj) {
                    const int col = u.pn * BM + bj * HALF + wc * 32 + 8 * fq;
                    const u32x4 ga = *(const u32x4*)(z + (size_t)token * ZGP + ZGA + col), gb = *(const u32x4*)(z + (size_t)token * ZGP + ZGB + col);
                    const unsigned gaw[4] = {ga.x, ga.y, ga.z, ga.w}, gbw[4] = {gb.x, gb.y, gb.z, gb.w};
#pragma unroll
                    for (int q = 0; q < 4; ++q) {
                        const float r0 = bf_lo(gaw[q]) * __builtin_amdgcn_rcpf(fmaxf(bf_lo(gbw[q]), 1e-30f)), r1 = bf_hi(gaw[q]) * __builtin_amdgcn_rcpf(fmaxf(bf_hi(gbw[q]), 1e-30f));
                        acc[ai][bj][m][q >> 1][2 * (q & 1)] *= r0; acc[ai][bj][m][q >> 1][2 * (q & 1) + 1] *= r1;
                    }
                }
            }
    }
    __device__ __forceinline__ void operator()(const f32x4 (&acc)[2][2][4][2], const Unit& u, int wr, int wc, int fr, int fq) const {
#pragma unroll
        for (int ai = 0; ai < 2; ++ai)
#pragma unroll
            for (int m = 0; m < 4; ++m) {
                const int token = u.pm * BM + ai * HALF + wr * 64 + m * 16 + fr;
#pragma unroll
                for (int bj = 0; bj < 2; ++bj) {
                    const int col = u.pn * BM + bj * HALF + wc * 32 + 8 * fq;
                    const u32x4 gw = *(const u32x4*)(z + (size_t)token * ZGP + ZGB + col);
                    f32x4 v0 = acc[ai][bj][m][0], v1 = acc[ai][bj][m][1];
                    v0[0] *= fmaxf(bf_lo(gw.x), 1e-30f); v0[1] *= fmaxf(bf_hi(gw.x), 1e-30f); v0[2] *= fmaxf(bf_lo(gw.y), 1e-30f); v0[3] *= fmaxf(bf_hi(gw.y), 1e-30f);
                    v1[0] *= fmaxf(bf_lo(gw.z), 1e-30f); v1[1] *= fmaxf(bf_hi(gw.z), 1e-30f); v1[2] *= fmaxf(bf_lo(gw.w), 1e-30f); v1[3] *= fmaxf(bf_hi(gw.w), 1e-30f);
                    u32x4 w; w.x = cvt_pk_bf16(v0[0], v0[1]); w.y = cvt_pk_bf16(v0[2], v0[3]); w.z = cvt_pk_bf16(v1[0], v1[1]); w.w = cvt_pk_bf16(v1[2], v1[3]);
                    *(u32x4*)(mb + (size_t)token * DM + col) = w;
                }
            }
    }
};
struct EpiWo {
    static constexpr bool PERM = true, AFTER_DRAIN = false; static constexpr int HOOK_T = 0;
    const float* xp; const float* xs; bf16_t* x1b; float* rowsq;
    __device__ __forceinline__ void operator()(const f32x4 (&acc)[2][2][4][2], const Unit& u, int wr, int wc, int fr, int fq) const {
#pragma unroll
        for (int ai = 0; ai < 2; ++ai)
#pragma unroll
            for (int m = 0; m < 4; ++m) {
                const int token = u.pm * BM + ai * HALF + wr * 64 + m * 16 + fr;
                const float* xr = (token < NPROMPT) ? xp + (size_t)token * DM : xs + (size_t)(token - NPROMPT) * DM;
                const bool valid = token < NVALID;
                float ss = 0.f;
#pragma unroll
                for (int bj = 0; bj < 2; ++bj) {
                    const int col = u.pn * BM + bj * HALF + wc * 32 + 8 * fq;
                    f32x4 a0 = (f32x4){0.f, 0.f, 0.f, 0.f}, a1 = a0;
                    if (valid) { a0 = *(const f32x4*)(xr + col); a1 = *(const f32x4*)(xr + col + 4); }
                    const f32x4 v0 = acc[ai][bj][m][0] + a0, v1 = acc[ai][bj][m][1] + a1;
                    ss += (v0[0] * v0[0] + v0[1] * v0[1]) + (v0[2] * v0[2] + v0[3] * v0[3]) + (v1[0] * v1[0] + v1[1] * v1[1]) + (v1[2] * v1[2] + v1[3] * v1[3]);
                    u32x4 w; w.x = cvt_pk_bf16(v0[0], v0[1]); w.y = cvt_pk_bf16(v0[2], v0[3]); w.z = cvt_pk_bf16(v1[0], v1[1]); w.w = cvt_pk_bf16(v1[2], v1[3]);
                    *(u32x4*)(x1b + (size_t)token * DM + col) = w;
                }
                ss += __shfl_xor(ss, 16); ss += __shfl_xor(ss, 32);
                if (fq == 0) atomicAdd(rowsq + token, ss);
            }
    }
};
struct EpiGU {
    static constexpr bool PERM = true, AFTER_DRAIN = false; static constexpr int HOOK_T = 0;
    const float* rowsq; bf16_t* hh;
    __device__ __forceinline__ void operator()(const f32x4 (&acc)[2][2][4][2], const Unit& u, int wr, int wc, int fr, int fq) const {
#pragma unroll
        for (int ai = 0; ai < 2; ++ai)
#pragma unroll
            for (int m = 0; m < 4; ++m) {
                const int token = u.pm * BM + ai * HALF + wr * 64 + m * 16 + fr;
                const float rs = __builtin_amdgcn_rsqf(rowsq[token] * (1.0f / DM) + NORM_EPS);
                f32x4 o[2];
#pragma unroll
                for (int n = 0; n < 2; ++n) {
                    const f32x4 g = acc[ai][0][m][n] * rs, uu = acc[ai][1][m][n] * rs;
#pragma unroll
                    for (int e = 0; e < 4; ++e) o[n][e] = g[e] * uu[e] * sigmoidf_(g[e]);
                }
                u32x4 w; w.x = cvt_pk_bf16(o[0][0], o[0][1]); w.y = cvt_pk_bf16(o[0][2], o[0][3]); w.z = cvt_pk_bf16(o[1][0], o[1][1]); w.w = cvt_pk_bf16(o[1][2], o[1][3]);
                *(u32x4*)(hh + (size_t)token * DFF + u.pn * HALF + wc * 32 + 8 * fq) = w;
            }
    }
};
struct EpiDown {
    static constexpr bool PERM = true, AFTER_DRAIN = false; static constexpr int HOOK_T = 0;
    const bf16_t* x1b; const float* gf; float* out; float* rowsq;
    __device__ __forceinline__ void operator()(const f32x4 (&acc)[2][2][4][2], const Unit& u, int wr, int wc, int fr, int fq) const {
        f32x4 gv[2][2];
#pragma unroll
        for (int bj = 0; bj < 2; ++bj)
#pragma unroll
            for (int n = 0; n < 2; ++n) gv[bj][n] = *(const f32x4*)(gf + u.pn * BM + bj * HALF + wc * 32 + 8 * fq + 4 * n);
#pragma unroll
        for (int ai = 0; ai < 2; ++ai)
#pragma unroll
            for (int m = 0; m < 4; ++m) {
                const int token = u.pm * BM + ai * HALF + wr * 64 + m * 16 + fr;
                if (token >= NVALID) continue;
                float ss = 0.f;
#pragma unroll
                for (int bj = 0; bj < 2; ++bj) {
                    const int col = u.pn * BM + bj * HALF + wc * 32 + 8 * fq;
                    const u32x4 xw = *(const u32x4*)(x1b + (size_t)token * DM + col);
                    const f32x4 v0 = acc[ai][bj][m][0] + (f32x4){bf_lo(xw.x), bf_hi(xw.x), bf_lo(xw.y), bf_hi(xw.y)}, v1 = acc[ai][bj][m][1] + (f32x4){bf_lo(xw.z), bf_hi(xw.z), bf_lo(xw.w), bf_hi(xw.w)};
                    ss += (v0[0] * v0[0] + v0[1] * v0[1]) + (v0[2] * v0[2] + v0[3] * v0[3]) + (v1[0] * v1[0] + v1[1] * v1[1]) + (v1[2] * v1[2] + v1[3] * v1[3]);
                    float* op = out + O_Y + (size_t)token * DM + col; *(f32x4*)op = v0 * gv[bj][0]; *(f32x4*)(op + 4) = v1 * gv[bj][1];
                }
                ss += __shfl_xor(ss, 16); ss += __shfl_xor(ss, 32);
                if (fq == 0) atomicAdd(rowsq + token, ss);
            }
    }
};
constexpr int SK_P = 144, SK_B = 128 * SK_P;
template <class Epi>
__device__ __forceinline__ void skinny_gemm(PG8_LAS unsigned char* lds, const Gemm g, int pn, const Epi& E) {
    int tid_ = threadIdx.x; asm volatile("" : "+v"(tid_));
    const int tid = tid_, wid = __builtin_amdgcn_readfirstlane(tid >> 6), lane = tid & 63, wr = wid >> 2, wc = wid & 3, fr = lane & 15, fq = lane >> 4;
    const int K = g.K, ns = K / 64;
    f32x4 acc[2][2][4][2];
#pragma unroll
    for (int a = 0; a < 2; ++a)
#pragma unroll
        for (int b = 0; b < 2; ++b)
#pragma unroll
            for (int m = 0; m < 4; ++m)
#pragma unroll
                for (int n = 0; n < 2; ++n) acc[a][b][m][n] = (f32x4){0.f, 0.f, 0.f, 0.f};
    const int srow = tid >> 3, sch = tid & 7;
    const bf16_t* gA = g.A + (size_t)(NPROMPT + srow) * K + sch * 8;
    const bf16_t* gB = g.Bt + (size_t)(BM * pn + srow) * K + sch * 8;
    const int lst = srow * SK_P + sch * 16;
    u32x4 st0[6], st1[6];
#define SK_LOAD(dst, s_) do { _Pragma("unroll") for (int j = 0; j < 2; ++j) dst[j] = *(const u32x4*)(gA + (size_t)(64 * j) * K + 64 * (s_)); \
                              _Pragma("unroll") for (int j = 0; j < 4; ++j) dst[2 + j] = *(const u32x4*)(gB + (size_t)(64 * j) * K + 64 * (s_)); } while (0)
#define SK_WRITE(src) do { _Pragma("unroll") for (int j = 0; j < 2; ++j) *(PG8_LAS u32x4*)(lds + lst + 64 * j * SK_P) = src[j]; \
                           _Pragma("unroll") for (int j = 0; j < 4; ++j) *(PG8_LAS u32x4*)(lds + SK_B + lst + 64 * j * SK_P) = src[2 + j]; } while (0)
    const int aoff = (wr * 64 + fr) * SK_P + fq * 16;
    int boff[2][2];
#pragma unroll
    for (int bj = 0; bj < 2; ++bj)
#pragma unroll
        for (int n = 0; n < 2; ++n) boff[bj][n] = SK_B + (HALF * bj + 32 * wc + perm32(16 * n + fr)) * SK_P + fq * 16;
#define SK_COMPUTE() do { _Pragma("unroll") for (int kh = 0; kh < 2; ++kh) { bf16x8 a[4], b[2][2]; \
        _Pragma("unroll") for (int m = 0; m < 4; ++m) a[m] = *(const PG8_LAS bf16x8*)(lds + aoff + m * 16 * SK_P + kh * 64); \
        _Pragma("unroll") for (int bj = 0; bj < 2; ++bj) _Pragma("unroll") for (int n = 0; n < 2; ++n) b[bj][n] = *(const PG8_LAS bf16x8*)(lds + boff[bj][n] + kh * 64); \
        _Pragma("unroll") for (int bj = 0; bj < 2; ++bj) _Pragma("unroll") for (int m = 0; m < 4; ++m) _Pragma("unroll") for (int n = 0; n < 2; ++n) \
            acc[0][bj][m][n] = __builtin_amdgcn_mfma_f32_16x16x32_bf16(b[bj][n], a[m], acc[0][bj][m][n], 0, 0, 0); } } while (0)
    SK_LOAD(st0, 0); if (ns > 1) SK_LOAD(st1, 1);
    for (int s = 0; s < ns; s += 2) {
        if constexpr (Epi::HOOK_T > 0) { if (s == Epi::HOOK_T) E.mid(acc, Unit{NPROMPT / BM, pn}, wr, wc, fr, fq); }
        __syncthreads(); SK_WRITE(st0); if (s + 2 < ns) SK_LOAD(st0, s + 2); __syncthreads(); SK_COMPUTE();
        __syncthreads(); SK_WRITE(st1); if (s + 3 < ns) SK_LOAD(st1, s + 3); __syncthreads(); SK_COMPUTE();
    }
    __syncthreads();
#undef SK_LOAD
#undef SK_WRITE
#undef SK_COMPUTE
    Unit u; u.pm = NPROMPT / BM; u.pn = pn;
    E(acc, u, wr, wc, fr, fq);
}
}
#define GAS __attribute__((address_space(1)))
#define LAS __attribute__((address_space(3)))
typedef unsigned short bf16;
typedef unsigned v4u __attribute__((ext_vector_type(4)));
typedef float f32x4 __attribute__((ext_vector_type(4)));
typedef short bf16x8 __attribute__((ext_vector_type(8)));
typedef GAS unsigned gu32;
typedef GAS unsigned long long gu64;
#define RLX_AGENT __ATOMIC_RELAXED, __HIP_MEMORY_SCOPE_AGENT
#define LDS_WAIT() asm volatile("s_waitcnt lgkmcnt(0)" ::: "memory")
#define VM_WAIT() asm volatile("s_waitcnt vmcnt(0)" ::: "memory")
__device__ __forceinline__ unsigned long long rt() { return __builtin_amdgcn_s_memrealtime(); }
__device__ __forceinline__ unsigned f2bf(float f) { unsigned u = __builtin_bit_cast(unsigned, f); return (u + 0x7fffu + ((u >> 16) & 1u)) >> 16; }
__device__ __forceinline__ unsigned pk2(float lo, float hi) { return f2bf(lo) | (f2bf(hi) << 16); }

#define XB_TMO      128
#define XB_XCNT(j)  (256  + 64 * (j))
#define XB_XSUB(j)  (1280 + 64 * (j))
#define XB_XGEN(j)  (2304 + 64 * (j))
#define XB_TOP      3328
#define XB_TOPGEN   3392
#define XCD_BAR_WORDS 3456
#define XB_SPIN_CAP (1u << 18)

__device__ __forceinline__ unsigned xb_ld(unsigned* p)              { return __hip_atomic_load(p, __ATOMIC_RELAXED, __HIP_MEMORY_SCOPE_AGENT); }
__device__ __forceinline__ unsigned xb_add(unsigned* p, unsigned v) { return __hip_atomic_fetch_add(p, v, __ATOMIC_RELAXED, __HIP_MEMORY_SCOPE_AGENT); }
__device__ __forceinline__ unsigned xb_xcc_id() { return (unsigned)__builtin_amdgcn_s_getreg((3 << 11) | 20) & 0xFu; }
#define XB_SPIN(cond, bar) do { unsigned _sp = 0; while (cond) { __builtin_amdgcn_s_sleep(1); \
    if ((++_sp & 255u) == 0u) { if (xb_ld(&(bar)[XB_TMO])) break; if (_sp > XB_SPIN_CAP) { atomicAdd(&(bar)[XB_TMO], 1u); break; } } } } while (0)

struct XcdBarrier {
    unsigned* bar; unsigned x;
    volatile LAS unsigned* st;
};

__device__ __forceinline__ XcdBarrier xcd_barrier_post(unsigned* bar, volatile LAS unsigned* st) {
    XcdBarrier b; b.bar = bar; b.x = xb_xcc_id(); b.st = st;
    if (threadIdx.x == 0) (void)xb_add(&bar[XB_XCNT(b.x)], 1u);
    return b;
}
__device__ __forceinline__ void xcd_barrier_complete(unsigned* bar, unsigned x, unsigned& nloc, unsigned& nx) {
    const unsigned G = gridDim.x * gridDim.y * gridDim.z;
    unsigned sum, cnt, mine, sp = 0u;
    for (;;) {
        sum = 0u; cnt = 0u; mine = 0u;
#pragma unroll
        for (unsigned j = 0; j < 16; ++j) { const unsigned c = xb_ld(&bar[XB_XCNT(j)]); sum += c; cnt += (c > 0u) ? 1u : 0u; mine = (j == x) ? c : mine; }
        if (sum == G) break;
        __builtin_amdgcn_s_sleep(1);
        if ((++sp & 255u) == 0u) { if (xb_ld(&bar[XB_TMO])) break; if (sp > XB_SPIN_CAP) { atomicAdd(&bar[XB_TMO], 1u); break; } }
    }
    nloc = mine > 0u ? mine : 1u; nx = cnt > 0u ? cnt : 1u;
}

__device__ __forceinline__ void xcd_barrier(const XcdBarrier& b) {
    asm volatile("s_waitcnt vmcnt(0)" ::: "memory");
    __syncthreads();
    if (threadIdx.x == 0) {
        unsigned* bar = b.bar;
        __builtin_amdgcn_s_waitcnt(0);
        unsigned nloc = b.st[0], nx = b.st[1];
        if (nloc == 0u) { xcd_barrier_complete(bar, b.x, nloc, nx); b.st[0] = nloc; b.st[1] = nx; }
        const unsigned old = xb_add(&bar[XB_XSUB(b.x)], 1u);
        const unsigned gen = old / nloc;
        if (old + 1u == (gen + 1u) * nloc) {
            __builtin_amdgcn_fence(__ATOMIC_RELEASE, "agent");
            asm volatile("s_waitcnt vmcnt(0)" ::: "memory");
            const unsigned og = xb_add(&bar[XB_TOP], 1u);
            const unsigned tg = og / nx;
            if (og + 1u == (tg + 1u) * nx) xb_add(&bar[XB_TOPGEN], 1u);
            else XB_SPIN(xb_ld(&bar[XB_TOPGEN]) == tg, bar);
            __builtin_amdgcn_fence(__ATOMIC_ACQUIRE, "agent");
            xb_add(&bar[XB_XGEN(b.x)], 1u);
            asm volatile("s_waitcnt vmcnt(0)" ::: "memory");
        } else {
            XB_SPIN(xb_ld(&bar[XB_XGEN(b.x)]) == gen, bar);
            __builtin_amdgcn_fence(__ATOMIC_ACQUIRE, "agent");
            asm volatile("s_waitcnt vmcnt(0)" ::: "memory");
        }
    }
    __syncthreads();
}
__device__ __forceinline__ float bf2f(bf16 v) { return __uint_as_float((unsigned)v << 16); }
namespace att {
typedef float f32x16 __attribute__((ext_vector_type(16)));
typedef short bf16x8 __attribute__((ext_vector_type(8)));
typedef short s16x4 __attribute__((ext_vector_type(4)));
typedef short v4i16_t __attribute__((ext_vector_type(4)));
typedef unsigned u32x4 __attribute__((ext_vector_type(4)));
typedef unsigned u32x2 __attribute__((ext_vector_type(2)));
constexpr int KP = 144;
constexpr int LK = 0, LV = 384 * KP;
constexpr int LSC = LV + 12 * 4096;
constexpr int ATT_LDS = LSC + 8 * 1024;
__device__ __forceinline__ int crow(int r, int hi) { return (r & 3) + 8 * (r >> 2) + 4 * hi; }
__device__ __forceinline__ s16x4 vtr(LAS const unsigned char* p) { return __builtin_bit_cast(s16x4, __builtin_amdgcn_ds_read_tr16_b64_v4i16((LAS v4i16_t*)p)); }
__device__ __forceinline__ unsigned pkbf(float lo, float hi) { typedef float f2 __attribute__((ext_vector_type(2))); typedef __bf16 b2 __attribute__((ext_vector_type(2))); f2 v = {lo, hi}; b2 b = __builtin_convertvector(v, b2); return __builtin_bit_cast(unsigned, b); }
__device__ __forceinline__ float swapmax(float m) { auto rr = __builtin_amdgcn_permlane32_swap(__float_as_uint(m), __float_as_uint(m), false, false); return fmaxf(__uint_as_float(rr[0]), __uint_as_float(rr[1])); }
__device__ __forceinline__ float swapsum(float m) { auto rr = __builtin_amdgcn_permlane32_swap(__float_as_uint(m), __float_as_uint(m), false, false); return __uint_as_float(rr[0]) + __uint_as_float(rr[1]); }

struct SlotMap { int row0, s_lo; };
struct UDesc { SlotMap sm; int karr, varr, nslots, slot_base, tlo; bool has_sink; float sink2; const bf16* qrow; bf16* orow; float* lsep; };
__device__ __forceinline__ UDesc make_desc(int u, int wave, int lane, const bf16* QKV, bf16* OA, bf16* OG, float* LSE, const float* sinks) {
    UDesc d; const int i = lane & 31;
    if (u < 2048) {
        const int b = u >> 7, kvh = (u >> 6) & 1, pb = u & 63, p0 = pb * 32;
        d.sm = SlotMap{b * SEQ + p0 - 128, 128 - p0}; d.karr = HKA + kvh; d.varr = HVA + kvh; d.nslots = 160; d.slot_base = 0; d.tlo = (4 - pb) > 0 ? (4 - pb) : 0;
        const int head = kvh * 8 + wave, tok = b * SEQ + p0 + i;
        d.has_sink = true; d.sink2 = sinks[head] * LOG2E; d.qrow = QKV + (size_t)(HQA + head) * HEADSZ + (size_t)tok * 64; d.orow = OA + (size_t)tok * KAB + head * 64; d.lsep = nullptr;
    } else {
        const int v = u - 2048; const int u8 = v & 7, h = (v >> 3) & 3, g = (v >> 5) % 3, b = v / 96;
        d.karr = HKB + 4 * g + h; d.varr = HVB + 4 * g + h; int qrowi, qtok;
        if (g == 0) { const int n0 = 256 * u8; d.sm = SlotMap{b * SEQ + n0 - 128, 128 - n0}; d.nslots = 384; d.slot_base = 32 * wave; d.tlo = (u8 == 0 && 4 - wave > 0) ? 4 - wave : 0; qrowi = b * SEQ + n0 + 32 * wave + i; qtok = qrowi; }
        else if (g == 1) { const int r = u8 & 3, n0 = 256 * (u8 >> 2); d.sm = SlotMap{b * SEQ + r * 512 + n0 - 128, 128 - n0}; d.nslots = 384; d.slot_base = 32 * wave; d.tlo = ((u8 >> 2) == 0 && 4 - wave > 0) ? 4 - wave : 0;
            qrowi = b * SEQ + r * 512 + n0 + 32 * wave + i; qtok = b * SEQ + r + 4 * (n0 + 32 * wave + i); }
        else { d.sm = SlotMap{b * SEQ + 2 * u8 * 128, 0}; d.nslots = 256; const int res = 2 * u8 + (wave >> 2), blk = wave & 3; d.slot_base = 128 * (wave >> 2) + 32 * (blk - 4); d.tlo = 4 - blk;
            qrowi = b * SEQ + res * 128 + 32 * blk + i; qtok = b * SEQ + res + 16 * (32 * blk + i); }
        d.has_sink = false; d.sink2 = 0.f; d.qrow = QKV + (size_t)(HQB + 4 * g + h) * HEADSZ + (size_t)qrowi * 64; d.orow = OG + ((size_t)g * MTOK + qtok) * 256 + h * 64; d.lsep = LSE + ((size_t)g * MTOK + qtok) * 4 + h;
    }
    return d;
}
__device__ __forceinline__ void unit_load(const UDesc& d, const bf16* QKV, int tid, int lane, u32x4 (&kq)[6], u32x4 (&vq)[6], bf16x8 (&qn)[4]) {
    const bf16* kb = QKV + (size_t)d.karr * HEADSZ + (size_t)d.sm.row0 * 64; const bf16* vb = QKV + (size_t)d.varr * HEADSZ + (size_t)d.sm.row0 * 64;
#pragma unroll
    for (int it = 0; it < 6; ++it) {
        int id = tid + it * 512; id = id < d.nslots * 8 ? id : d.nslots * 8 - 1; id = id >= d.sm.s_lo * 8 ? id : d.sm.s_lo * 8;
        kq[it] = *(const u32x4*)(kb + (size_t)id * 8); vq[it] = *(const u32x4*)(vb + (size_t)id * 8);
    }
#pragma unroll
    for (int ks = 0; ks < 4; ++ks) qn[ks] = *(const bf16x8*)(d.qrow + 16 * ks + 8 * (lane >> 5));
}
__device__ __forceinline__ void unit_write(LAS unsigned char* lds, const SlotMap& sm, int nslots, int tid, const u32x4 (&kq)[6], const u32x4 (&vq)[6]) {
#pragma unroll
    for (int it = 0; it < 6; ++it) {
        const int id = tid + it * 512; const int s = id >> 3, c = id & 7;
        if (id < nslots * 8 && s >= sm.s_lo) { *(LAS u32x4*)(lds + LK + s * KP + c * 16) = kq[it];
            *(LAS u32x4*)(lds + LV + (s >> 5) * 4096 + (c >> 2) * 2048 + (s & 31) * 64 + (c & 3) * 16) = vq[it]; }
    }
}
__device__ __forceinline__ void attn_wave(LAS unsigned char* lds, const bf16x8 (&qr)[4], int slot_base, int t_lo, bool has_sink, float sink2, bf16* orow, float* lsep, int lane) {
    const int i = lane & 31, h = lane >> 5;
    f32x16 st[5];
    const float NEG = -INFINITY;
#pragma unroll
    for (int t = 0; t < 5; ++t) {
        if (t >= t_lo) {
            LAS const unsigned char* kp = lds + LK + (slot_base + 32 * t + i) * KP + h * 16;
            f32x16 acc = {};
#pragma unroll
            for (int ks = 0; ks < 4; ++ks) { const bf16x8 kf = *(LAS const bf16x8*)(kp + ks * 32); acc = __builtin_amdgcn_mfma_f32_32x32x16_bf16(kf, qr[ks], acc, 0, 0, 0); }
            st[t] = acc;
        } else {
#pragma unroll
            for (int r = 0; r < 16; ++r) st[t][r] = NEG;
        }
    }
#pragma unroll
    for (int r = 0; r < 16; ++r) { const int j = crow(r, h); if (j < i) st[0][r] = NEG; if (j > i) st[4][r] = NEG; }
    float m = NEG;
#pragma unroll
    for (int t = 0; t < 5; ++t)
#pragma unroll
        for (int r = 0; r < 16; ++r) m = fmaxf(m, st[t][r]);
    m = swapmax(m);
    if (has_sink) m = fmaxf(m, sink2);
    float l = 0.f;
#pragma unroll
    for (int t = 0; t < 5; ++t)
#pragma unroll
        for (int r = 0; r < 16; ++r) { st[t][r] = __builtin_amdgcn_exp2f(st[t][r] - m); l += st[t][r]; }
    l = swapsum(l);
    if (has_sink) l += __builtin_amdgcn_exp2f(sink2 - m);
    f32x16 o[2]; o[0] = (f32x16){}; o[1] = (f32x16){};
    const int vlane = (4 * h + ((lane & 15) >> 2)) * 64 + ((lane >> 4) & 1) * 32 + (lane & 3) * 8;
#pragma unroll
    for (int t = 0; t < 5; ++t) {
        if (t >= t_lo) {
            LAS const unsigned char* vt = lds + LV + ((slot_base >> 5) + t) * 4096 + vlane;
#pragma unroll
            for (int s = 0; s < 2; ++s) {
                u32x4 pw; pw.x = pkbf(st[t][8 * s + 0], st[t][8 * s + 1]); pw.y = pkbf(st[t][8 * s + 2], st[t][8 * s + 3]); pw.z = pkbf(st[t][8 * s + 4], st[t][8 * s + 5]); pw.w = pkbf(st[t][8 * s + 6], st[t][8 * s + 7]);
                const bf16x8 pb = __builtin_bit_cast(bf16x8, pw);
#pragma unroll
                for (int blk = 0; blk < 2; ++blk) {
                    const s16x4 lo = vtr(vt + blk * 2048 + s * 1024), hi = vtr(vt + blk * 2048 + s * 1024 + 512);
                    const bf16x8 va = (bf16x8){lo[0], lo[1], lo[2], lo[3], hi[0], hi[1], hi[2], hi[3]};
                    o[blk] = __builtin_amdgcn_mfma_f32_32x32x16_bf16(va, pb, o[blk], 0, 0, 0);
                }
            }
        }
    }
    const float inv = 1.0f / l;
#pragma unroll
    for (int blk = 0; blk < 2; ++blk)
#pragma unroll
        for (int rg = 0; rg < 4; ++rg) {
            u32x2 w; w.x = pkbf(o[blk][4 * rg + 0] * inv, o[blk][4 * rg + 1] * inv); w.y = pkbf(o[blk][4 * rg + 2] * inv, o[blk][4 * rg + 3] * inv);
            *(u32x2*)(orow + 32 * blk + 8 * rg + 4 * h) = w;
        }
    if (lsep && h == 0) *lsep = m + __builtin_amdgcn_logf(l);
}
__device__ __forceinline__ float wsum(float v) {
#pragma unroll
    for (int o = 1; o < 64; o <<= 1) v += __shfl_xor(v, o);
    return v;
}
__device__ __forceinline__ float wmax(float v) {
#pragma unroll
    for (int o = 1; o < 64; o <<= 1) v = fmaxf(v, __shfl_xor(v, o));
    return v;
}
__device__ __forceinline__ float red16(float v) { v += __shfl_xor(v, 1); v += __shfl_xor(v, 2); v += __shfl_xor(v, 4); v += __shfl_xor(v, 8); return v; }
__device__ __forceinline__ void sample_wave(const bf16* qp, const bf16* knp, const bf16* vnp, const float* kc, const float* vc, int W, int d, int rp, bool has_sink, float sink2, bf16* orow, float* lsep, int lane) {
    const int kg = lane >> 4, d4 = (lane & 15) * 4;
    const u32x2 qw = *(const u32x2*)(qp + d4), kw = *(const u32x2*)(knp + d4), vw = *(const u32x2*)(vnp + d4);
    const float q0 = pg8::bf_lo(qw.x), q1 = pg8::bf_hi(qw.x), q2 = pg8::bf_lo(qw.y), q3 = pg8::bf_hi(qw.y);
    const float s0 = red16(q0 * pg8::bf_lo(kw.x) + q1 * pg8::bf_hi(kw.x) + q2 * pg8::bf_lo(kw.y) + q3 * pg8::bf_hi(kw.y));
    const float* kr = kc + (size_t)(W - d * (1 + kg)) * rp + d4; const float* vr = vc + (size_t)(W - d * (1 + kg)) * rp + d4; const long step = -(long)(4 * d) * rp;
    float sc[32];
#pragma unroll
    for (int it = 0; it < 32; ++it) { const f32x4 k4 = *(const f32x4*)(kr + it * step); sc[it] = q0 * k4[0] + q1 * k4[1] + q2 * k4[2] + q3 * k4[3]; }
    float m = s0;
#pragma unroll
    for (int it = 0; it < 32; ++it) { sc[it] = red16(sc[it]); m = fmaxf(m, sc[it]); }
    m = fmaxf(m, __shfl_xor(m, 16)); m = fmaxf(m, __shfl_xor(m, 32));
    if (has_sink) m = fmaxf(m, sink2);
    float l = 0.f; f32x4 o = (f32x4){0.f, 0.f, 0.f, 0.f};
#pragma unroll
    for (int it = 0; it < 32; ++it) { const float pv = __builtin_amdgcn_exp2f(sc[it] - m); l += pv; const f32x4 v4 = *(const f32x4*)(vr + it * step); o = o + v4 * pv; }
    l += __shfl_xor(l, 16); l += __shfl_xor(l, 32);
#pragma unroll
    for (int e = 0; e < 4; ++e) { o[e] += __shfl_xor(o[e], 16); o[e] += __shfl_xor(o[e], 32); }
    const float p0 = __builtin_amdgcn_exp2f(s0 - m); l += p0; if (has_sink) l += __builtin_amdgcn_exp2f(sink2 - m);
    o[0] += p0 * pg8::bf_lo(vw.x); o[1] += p0 * pg8::bf_hi(vw.x); o[2] += p0 * pg8::bf_lo(vw.y); o[3] += p0 * pg8::bf_hi(vw.y);
    const float inv = 1.0f / l;
    if (kg == 0) { u32x2 w; w.x = pk2(o[0] * inv, o[1] * inv); w.y = pk2(o[2] * inv, o[3] * inv); *(u32x2*)(orow + d4) = w; }
    if (lsep && lane == 0) *lsep = m + __builtin_amdgcn_logf(l);
}
}

constexpr size_t MiB = 1u << 20;
constexpr size_t WS_CTL = 0, CTL_ZERO_BYTES = 1 * MiB;
constexpr size_t WS_ROPE = 2 * MiB;
constexpr size_t WS_WIN = 4 * MiB, WS_WGU = 16 * MiB, WS_WDN = 28 * MiB, WS_WPA = 34 * MiB, WS_WPB = 36 * MiB, WS_WO = 37 * MiB;
constexpr size_t WS_LSE = 40 * MiB;
constexpr size_t WS_XN = 64 * MiB, WS_QKV = 130 * MiB, WS_Z = 358 * MiB, WS_OA = 488 * MiB, WS_OB = 554 * MiB, WS_OG = 572 * MiB, WS_TMP = 622 * MiB, WS_MB = 752 * MiB;
constexpr size_t WS_X1 = 818 * MiB, WS_XB2 = 948 * MiB, WS_HH = 1014 * MiB, WS_END = 1192 * MiB;
static_assert(WS_QKV + (size_t)NHEADARR * HEADSZ * 2 <= WS_Z && WS_Z + (size_t)MTOK * ZGP * 2 <= WS_OA, "ws map");
constexpr int CW_DONE = 512, CW_CPH = 1536, CW_SBAR = 1600, CW_AQ = 1664;
constexpr int CW_BAR = 4096;
constexpr int CW_RSQ2 = 65536, CW_RSQ3 = 131072;
static_assert((CW_RSQ3 + MTOK) * 4 <= (int)CTL_ZERO_BYTES, "ctl");

constexpr int RING_BYTES = 131072, MISC_OFF = RING_BYTES + 320, LDS_BYTES = 147456;
constexpr int NWAVES = 8;
constexpr int NPHASE = 10;
#ifndef PROBE_MULT
#define PROBE_MULT 0
#define PROBE_A 4
#define PROBE_B 6
#endif
#ifndef REP2
#define REP2 1
#endif
#ifndef REP3
#define REP3 1
#endif

__device__ const double INVF[32] = {1.0, 0.7498942093324559, 0.5623413251903491, 0.4216965034285822, 0.31622776601683794, 0.23713737056616552, 0.1778279410038923, 0.1333521432163324, 0.1, 0.07498942093324558, 0.05623413251903491, 0.042169650342858224, 0.03162277660168379, 0.023713737056616554, 0.01778279410038923, 0.01333521432163324, 0.01, 0.007498942093324558, 0.005623413251903491, 0.004216965034285823, 0.0031622776601683794, 0.0023713737056616554, 0.0017782794100389228, 0.001333521432163324, 0.001, 0.0007498942093324559, 0.0005623413251903491, 0.00042169650342858224, 0.00031622776601683794, 0.00023713737056616554, 0.00017782794100389227, 0.0001333521432163324};

__device__ __forceinline__ void sincos_d(double x, double& s, double& c) {
    const double n = __builtin_rint(x * 0.63661977236758134308);
    double r = x - n * 1.57079632679489655800e+00; r = r - n * 6.12323399573676603587e-17;
    const double r2 = r * r;
    double sp = -7.6471637318198164759e-13; sp = sp * r2 + 1.6059043836821614599e-10; sp = sp * r2 - 2.5052108385441718775e-08; sp = sp * r2 + 2.7557319223985890653e-06;
    sp = sp * r2 - 1.9841269841269841270e-04; sp = sp * r2 + 8.3333333333333333333e-03; sp = sp * r2 - 1.6666666666666666667e-01; const double sr = r + r * r2 * sp;
    double cp = 4.7794773323873852974e-14; cp = cp * r2 - 1.1470745597729724714e-11; cp = cp * r2 + 2.0876756987868098979e-09; cp = cp * r2 - 2.7557319223985890653e-07;
    cp = cp * r2 + 2.4801587301587301587e-05; cp = cp * r2 - 1.3888888888888888889e-03; cp = cp * r2 + 4.1666666666666666667e-02; const double cr = 1.0 - 0.5 * r2 + r2 * r2 * cp;
    const int q = ((int)n) & 3;
    s = (q == 0) ? sr : (q == 1) ? cr : (q == 2) ? -sr : -cr;
    c = (q == 0) ? cr : (q == 1) ? -sr : (q == 2) ? -cr : sr;
}

__device__ __forceinline__ void transpose_item(const float* W, int K, int N, bf16* WT, int k0, int n0, int dst_row0, LAS float* scr, int lane, int ldw, int koff, const float* kscale) {
    float wv[32];
#pragma unroll
    for (int i = 0; i < 32; ++i) wv[i] = W[(size_t)(k0 + 2 * i + (lane >> 5)) * N + n0 + (lane & 31)];
    if (kscale) {
#pragma unroll
        for (int i = 0; i < 32; ++i) wv[i] *= kscale[k0 + 2 * i + (lane >> 5)];
    }
#pragma unroll
    for (int i = 0; i < 32; ++i) scr[(2 * i + (lane >> 5)) * 33 + (lane & 31)] = wv[i];
    LDS_WAIT(); asm volatile("" ::: "memory");
    const int c = lane & 7;
#pragma unroll
    for (int j = 0; j < 4; ++j) { const int n = (lane >> 3) + 8 * j; const LAS float* s = scr + (8 * c) * 33 + n;
        v4u o; o.x = pk2(s[0 * 33], s[1 * 33]); o.y = pk2(s[2 * 33], s[3 * 33]); o.z = pk2(s[4 * 33], s[5 * 33]); o.w = pk2(s[6 * 33], s[7 * 33]);
        *(GAS v4u*)(WT + (size_t)(dst_row0 + n) * ldw + koff + k0 + 8 * c) = o; }
    LDS_WAIT(); asm volatile("" ::: "memory");
}
__device__ __forceinline__ float wave_sum(float v) {
#pragma unroll
    for (int o = 1; o < 64; o <<= 1) v += __shfl_xor(v, o);
    return v;
}
template <int W, int R>
__device__ __forceinline__ void copy_shift(const float* src, float* dst, int gtid, int gthreads) {
    constexpr int VPB = (W - 1) * R / 4, BPITCH = W * R / 4, TOTAL = NSAMP * VPB;
    const f32x4* s4 = (const f32x4*)src; f32x4* d4 = (f32x4*)dst;
    int id = gtid;
    for (; id + 3 * gthreads < TOTAL; id += 4 * gthreads) {
        f32x4 v[4]; int o[4];
#pragma unroll
        for (int k = 0; k < 4; ++k) { const int x = id + k * gthreads; const int b = x / VPB, w = x - b * VPB; o[k] = b * BPITCH + w; v[k] = __builtin_nontemporal_load(s4 + o[k] + R / 4); }
#pragma unroll
        for (int k = 0; k < 4; ++k) __builtin_nontemporal_store(v[k], d4 + o[k]);
    }
    for (; id < TOTAL; id += gthreads) { const int b = id / VPB, w = id - b * VPB; d4[b * BPITCH + w] = s4[b * BPITCH + w + R / 4]; }
}

struct Args { const float* in[16]; float* out; unsigned char* ws; int ph_lo, ph_hi; };

__global__ void __launch_bounds__(NWAVES * 64, 2) fwd(Args args) {
    extern __shared__ __attribute__((aligned(16))) unsigned char lds_raw[];
    LAS unsigned char* lds = (LAS unsigned char*)lds_raw;
    volatile LAS unsigned* MISC = (volatile LAS unsigned*)(lds + MISC_OFF);
    const int tid = threadIdx.x, lane = tid & 63, wave = __builtin_amdgcn_readfirstlane(tid >> 6);
    const int G = gridDim.x, bid = blockIdx.x;
    unsigned char* ws = args.ws;
    gu32* ctl = (gu32*)(ws + WS_CTL);
    const float* x_prompt = args.in[0]; const float* x_sample = args.in[1];
    const float* cache_a = args.in[2]; const float* cache_b1 = args.in[3]; const float* cache_b2 = args.in[4]; const float* cache_b3 = args.in[5];
    const float* norm1_g = args.in[6]; const float* w_in = args.in[7]; const float* sinks = args.in[8]; const float* w_pa = args.in[9]; const float* w_pb = args.in[10];
    const float* w_o = args.in[11]; const float* norm2_g = args.in[12]; const float* w_gu = args.in[13]; const float* w_down = args.in[14]; const float* final_g = args.in[15];
    float* out = args.out;
    float* cosT = (float*)(ws + WS_ROPE); float* sinT = (float*)(ws + WS_ROPE + 512 * 1024);
    bf16* Win_t = (bf16*)(ws + WS_WIN); bf16* Wgu_t = (bf16*)(ws + WS_WGU); bf16* Wdn_t = (bf16*)(ws + WS_WDN); bf16* Wpab_t = (bf16*)(ws + WS_WPA); bf16* Wo_t = (bf16*)(ws + WS_WO);
    float* LSE = (float*)(ws + WS_LSE);
    bf16* XN = (bf16*)(ws + WS_XN); bf16* QKV = (bf16*)(ws + WS_QKV); bf16* Z = (bf16*)(ws + WS_Z);     bf16* OAB = (bf16*)(ws + WS_OA);     bf16* OG = (bf16*)(ws + WS_OG);
    bf16* MB = (bf16*)(ws + WS_MB); bf16* X1B = (bf16*)(ws + WS_XB2); bf16* HH = (bf16*)(ws + WS_HH);
    float* RSQ2 = (float*)(ws + WS_CTL) + CW_RSQ2; float* RSQ3 = (float*)(ws + WS_CTL) + CW_RSQ3;

    for (int u = tid; u < (LDS_BYTES - RING_BYTES) / 4; u += NWAVES * 64) ((LAS unsigned*)(lds + RING_BYTES))[u] = 0u;
    __syncthreads();
    const int lo = args.ph_lo, hi = args.ph_hi;
    XcdBarrier bar; bar.bar = (unsigned*)(ctl + CW_BAR); bar.x = 0; bar.st = nullptr;
    if (hi - lo > 1) bar = xcd_barrier_post((unsigned*)(ctl + CW_BAR), MISC + 8);
#define IN(k) (lo <= (k) && (k) < hi)
#define STAMP(i) do { if (PROBE_MULT > 0 && bid == 0 && tid == 0) { const unsigned long long t_ = rt(); MISC[32 + 2 * (i)] = (unsigned)t_; MISC[33 + 2 * (i)] = (unsigned)(t_ >> 32); } } while (0)
    STAMP(0);
#define FILL_FETCH(cond, dst) do { __syncthreads(); if (tid == 0) { unsigned c_ = 0xffffffffu; if (cond) c_ = __hip_atomic_fetch_add(ctl + CW_CPH, 1u, RLX_AGENT); MISC[16] = c_; } __syncthreads(); dst = MISC[16]; } while (0)
#define FILL_BODY(cond) do { if (tid == 0) __hip_atomic_fetch_add(ctl + CW_DONE + 64 * fill_k, 1u, RLX_AGENT); \
        unsigned c0, c1; FILL_FETCH(cond, c0); \
        if (c0 < (unsigned)pg8::CP_NCHUNK) { f32x4 cda[pg8::CP_NL], cdb[pg8::CP_NL]; cpj.load((int)c0, tid, cda); \
            for (;;) { FILL_FETCH(cond, c1); if (c1 < (unsigned)pg8::CP_NCHUNK) cpj.load((int)c1, tid, cdb); cpj.store((int)c0, tid, cda); if (c1 >= (unsigned)pg8::CP_NCHUNK) break; \
                       FILL_FETCH(cond, c0); if (c0 < (unsigned)pg8::CP_NCHUNK) cpj.load((int)c0, tid, cda); cpj.store((int)c1, tid, cdb); if (c0 >= (unsigned)pg8::CP_NCHUNK) break; } } } while (0)
    const int gw = bid * NWAVES + wave, NGW = G * NWAVES;
    const pg8::CopyJob cpj{cache_a, cache_b1, cache_b2, cache_b3, out + O_SA, out + O_SB1, out + O_SB2, out + O_SB3};
    const int GS = G - 16; const bool roleB = bid >= GS;
#define AFTER(k) do { STAMP(2 * (k) + 1); if (IN(k) && ((k) == 1 || (k) == 7)) { if (!roleB) { if (tid == 0) __hip_atomic_fetch_add(ctl + CW_DONE + 64 * (k), 1u, RLX_AGENT); } else { const int fill_k = (k); FILL_BODY(__hip_atomic_load(ctl + CW_DONE + 64 * fill_k, RLX_AGENT) < (unsigned)G); } } if (IN(k) && IN((k) + 1)) xcd_barrier(bar); STAMP(2 * (k) + 2); } while (0)
#define GBAR() do { asm volatile("s_waitcnt vmcnt(0)" ::: "memory"); __syncthreads(); if (tid == 0) { const unsigned ep = MISC[17] + 1u; MISC[17] = ep; __builtin_amdgcn_fence(__ATOMIC_RELEASE, "agent"); asm volatile("s_waitcnt vmcnt(0)" ::: "memory"); __hip_atomic_fetch_add(ctl + CW_SBAR, 1u, RLX_AGENT); const unsigned want = (unsigned)(G - GS) * ep; unsigned sp = 0; while (__hip_atomic_load(ctl + CW_SBAR, RLX_AGENT) < want) { __builtin_amdgcn_s_sleep(2); if (++sp > (1u << 22)) break; } __builtin_amdgcn_fence(__ATOMIC_ACQUIRE, "agent"); asm volatile("s_waitcnt vmcnt(0)" ::: "memory"); } __syncthreads(); } while (0)
#define ORDER(smp, wide) pg8::GenOrder S; S.init(smp, (wide) ? NIN : DM, (wide) ? GS : G, bid, G - GS, bid - GS)
    if (IN(0)) {
LAS float* scr = (LAS float*)(lds + wave * 16384);
constexpr int I_IN = 16 * 176, I_GU = 16 * 176, I_DN = 44 * 32, I_PA = 16 * 32, I_PB = 4 * 32, I_O = 16 * 32;
constexpr int NITEMS = I_IN + I_GU + I_DN + I_PA + I_PB + I_O;
for (int it = gw; it < NITEMS; it += NGW) {
    int r = it;
    if (r < I_IN) { const int kb = r / 176, nb = r % 176, n0 = 32 * nb, pn = n0 >> 8, within = n0 & 255, wc = within >> 6, bj = (within >> 5) & 1;
        transpose_item(w_in, DM, NIN, Win_t, 64 * kb, n0, 256 * pn + 128 * bj + 32 * wc, scr, lane, DM, 0, nullptr); continue; } r -= I_IN;
    if (r < I_GU) { const int kb = r / 176, nb = r % 176, n0 = 32 * nb; const int isu = n0 >= DFF, f0 = isu ? n0 - DFF : n0;
        transpose_item(w_gu, DM, NIN, Wgu_t, 64 * kb, n0, 256 * (f0 >> 7) + 128 * isu + (f0 & 127), scr, lane, DM, 0, norm2_g); continue; } r -= I_GU;
    if (r < I_DN) { const int kb = r / 32, nb = r % 32; transpose_item(w_down, DFF, DM, Wdn_t, 64 * kb, 32 * nb, 32 * nb, scr, lane, DFF, 0, nullptr); continue; } r -= I_DN;
    if (r < I_PA) { const int kb = r / 32, nb = r % 32; transpose_item(w_pa, DM, DM, Wpab_t, 64 * kb, 32 * nb, 32 * nb, scr, lane, KAB, 0, nullptr); continue; } r -= I_PA;
    if (r < I_PB) { const int kb = r / 32, nb = r % 32; transpose_item(w_pb, 256, DM, Wpab_t, 64 * kb, 32 * nb, 32 * nb, scr, lane, KAB, DM, nullptr); continue; } r -= I_PB;
    { const int kb = r / 32, nb = r % 32; transpose_item(w_o, DM, DM, Wo_t, 64 * kb, 32 * nb, 32 * nb, scr, lane, DM, 0, nullptr); }
}
for (int idx = bid * 512 + tid; idx < 2049 * 32; idx += G * 512) { const int p = idx >> 5, i = idx & 31; const double ang = (double)(p < 2048 ? p : PAST) * INVF[i]; double s, c; sincos_d(ang, s, c); cosT[idx] = (float)c; sinT[idx] = (float)s; }
{ f32x4 gv[4];
#pragma unroll
  for (int j = 0; j < 4; ++j) gv[j] = ((const f32x4*)norm1_g)[lane + 64 * j];
  for (int m = gw; m < MTOK; m += NGW) {
    GAS unsigned long long* o8 = (GAS unsigned long long*)(XN + (size_t)m * DM) + lane;
    if (m >= NVALID) {
#pragma unroll
        for (int j = 0; j < 4; ++j) o8[64 * j] = 0ull;
        continue; }
    const float* xrow = (m < NPROMPT) ? x_prompt + (size_t)m * DM : x_sample + (size_t)(m - NPROMPT) * DM;
    const GAS f32x4* xr = (const GAS f32x4*)xrow + lane;
    f32x4 v[4]; float s2 = 0.f;
#pragma unroll
    for (int j = 0; j < 4; ++j) { v[j] = xr[64 * j]; s2 += (v[j].x * v[j].x + v[j].y * v[j].y) + (v[j].z * v[j].z + v[j].w * v[j].w); }
    const float rstd = 1.0f / sqrtf(wave_sum(s2) * (1.f / DM) + NORM_EPS);
#pragma unroll
    for (int j = 0; j < 4; ++j) { const f32x4 t = v[j] * rstd * gv[j]; o8[64 * j] = (unsigned long long)pk2(t.x, t.y) | ((unsigned long long)pk2(t.z, t.w) << 32); }
  } }
        }
    AFTER(0);
    if (IN(1)) {
        pg8::Gemm g{XN, Win_t, MTOK, NIN, DM}; pg8::EpiIn E{QKV, Z, cosT, sinT, out};
        if (!roleB) { ORDER(false, true); pg8::gemm_phase<pg8::EpiIn, pg8::GenOrder, true, true>(lds, g, S, E); }
        else for (int pn = bid - GS; pn < NIN / 256; pn += G - GS) pg8::skinny_gemm<pg8::EpiIn>(lds, g, pn, E);
    }
    AFTER(1);
    if (IN(2)) {
{ constexpr int NU = 2048 + 1536;
  att::u32x4 kq[6], vq[6]; att::bf16x8 qn[4];
  if (tid == 0) { MISC[18] = __hip_atomic_fetch_add(ctl + CW_AQ, 1u, RLX_AGENT); MISC[19] = __hip_atomic_fetch_add(ctl + CW_AQ, 1u, RLX_AGENT); }
  __syncthreads();
  int u = (int)MISC[18], un = (int)MISC[19]; att::UDesc d = att::make_desc(u < NU ? u : 0, wave, lane, QKV, OAB, OG, LSE, sinks);
  if (u < NU) att::unit_load(d, QKV, tid, lane, kq, vq, qn);
  while (u < NU) {
    __syncthreads();
    att::unit_write(lds, d.sm, d.nslots, tid, kq, vq);
    att::bf16x8 qc[4];
#pragma unroll
    for (int ks = 0; ks < 4; ++ks) qc[ks] = qn[ks];
    const int c_sb = d.slot_base, c_tlo = d.tlo; const bool c_hs = d.has_sink; const float c_s2 = d.sink2; bf16* c_or = d.orow; float* c_ls = d.lsep;
    un = (int)MISC[19];
    __syncthreads();
    unsigned fetched = 0u; if (tid == 0) fetched = __hip_atomic_fetch_add(ctl + CW_AQ, 1u, RLX_AGENT);
    if (un < NU) { d = att::make_desc(un, wave, lane, QKV, OAB, OG, LSE, sinks); att::unit_load(d, QKV, tid, lane, kq, vq, qn); }
    att::attn_wave(lds, qc, c_sb, c_tlo, c_hs, c_s2, c_or, c_ls, lane);
    if (tid == 0) MISC[19] = fetched;
    u = un;
  } }
__syncthreads();
STAMP(22);
{
  for (int wt = gw; wt < NSAMP * 28; wt += NGW) {
    const int bs = wt / 28, job = wt % 28; const int tok = NPROMPT + bs;
#define HROW(arr) (QKV + (size_t)(arr) * HEADSZ + (size_t)tok * 64)
    if (job < 16) { const int kvh = job >> 3; const float* kc = cache_a + (size_t)bs * 128 * 256 + kvh * 64;
        att::sample_wave(HROW(HQA + job), HROW(HKA + kvh), HROW(HVA + kvh), kc, kc + 128, 128, 1, 256, true, sinks[job] * LOG2E, OAB + (size_t)tok * KAB + job * 64, nullptr, lane); }
    else { const int g = (job - 16) >> 2, h = (job - 16) & 3; const int W = 128 << (2 * g), d = 1 << (2 * g);
        const float* cb = (g == 0) ? cache_b1 : (g == 1) ? cache_b2 : cache_b3; const float* kc = cb + (size_t)bs * W * 512 + h * 64;
        att::sample_wave(HROW(HQB + 4 * g + h), HROW(HKB + 4 * g + h), HROW(HVB + 4 * g + h), kc, kc + 256, W, d, 512, false, 0.f,
                         OG + ((size_t)g * MTOK + tok) * 256 + h * 64, LSE + ((size_t)g * MTOK + tok) * 4 + h, lane); }
  } }
        }
    AFTER(2);
    if (IN(3)) {
for (int tok = gw; tok < NVALID; tok += NGW) {
    const int h = lane >> 4, d4 = (lane & 15) * 4;
    float ls[3]; att::u32x2 ov[3];
#pragma unroll
    for (int g = 0; g < 3; ++g) { ls[g] = LSE[((size_t)g * MTOK + tok) * 4 + h]; ov[g] = *(const att::u32x2*)(OG + ((size_t)g * MTOK + tok) * 256 + h * 64 + d4); }
    const float mx = fmaxf(fmaxf(ls[0], ls[1]), ls[2]);
    float w[3], ws_ = 0.f;
#pragma unroll
    for (int g = 0; g < 3; ++g) { w[g] = __builtin_amdgcn_exp2f(ls[g] - mx); ws_ += w[g]; }
    const float inv = 1.0f / ws_; float o0 = 0.f, o1 = 0.f, o2 = 0.f, o3 = 0.f;
#pragma unroll
    for (int g = 0; g < 3; ++g) { const float a = w[g] * inv; o0 += a * pg8::bf_lo(ov[g].x); o1 += a * pg8::bf_hi(ov[g].x); o2 += a * pg8::bf_lo(ov[g].y); o3 += a * pg8::bf_hi(ov[g].y); }
    att::u32x2 r; r.x = pk2(o0, o1); r.y = pk2(o2, o3);
    *(att::u32x2*)(OAB + (size_t)tok * KAB + DM + h * 64 + d4) = r;
}
        }
    AFTER(3);
    if (IN(5)) { pg8::Gemm g{OAB, Wpab_t, MTOK, DM, KAB}; pg8::EpiGate E{Z, MB}; ORDER(false, false); pg8::gemm_phase<pg8::EpiGate, pg8::GenOrder, true, true>(lds, g, S, E); }
    AFTER(5);
    if (IN(6)) { pg8::Gemm g{MB, Wo_t, MTOK, DM, DM}; pg8::EpiWo E{x_prompt, x_sample, X1B, RSQ2}; ORDER(false, false); pg8::gemm_phase<pg8::EpiWo, pg8::GenOrder, true, true>(lds, g, S, E); }
    AFTER(6);
    if (IN(7)) {
        if (!roleB) { pg8::Gemm g{X1B, Wgu_t, MTOK, NIN, DM}; pg8::EpiGU E{RSQ2, HH}; ORDER(false, true); pg8::gemm_phase<pg8::EpiGU, pg8::GenOrder, true, true>(lds, g, S, E); }
        else {
            const int c = bid - GS, NS = G - GS;
            if (c < 4) { pg8::Gemm g{OAB, Wpab_t, MTOK, DM, KAB}; pg8::EpiGate E{Z, MB}; pg8::skinny_gemm<pg8::EpiGate>(lds, g, c, E); }
            GBAR();
            if (c < 4) { pg8::Gemm g{MB, Wo_t, MTOK, DM, DM}; pg8::EpiWo E{x_prompt, x_sample, X1B, RSQ2}; pg8::skinny_gemm<pg8::EpiWo>(lds, g, c, E); }
            GBAR();
            { pg8::Gemm g{X1B, Wgu_t, MTOK, NIN, DM}; pg8::EpiGU E{RSQ2, HH}; for (int pn = c; pn < NIN / 256; pn += NS) pg8::skinny_gemm<pg8::EpiGU>(lds, g, pn, E); }
            GBAR();
            if (c < 4) { pg8::Gemm g{HH, Wdn_t, MTOK, DM, DFF}; pg8::EpiDown E{X1B, final_g, out, RSQ3}; pg8::skinny_gemm<pg8::EpiDown>(lds, g, c, E); }
        }
    }
    AFTER(7);
    if (IN(8)) { pg8::Gemm g{HH, Wdn_t, MTOK, DM, DFF}; pg8::EpiDown E{X1B, final_g, out, RSQ3}; ORDER(false, false); pg8::gemm_phase<pg8::EpiDown, pg8::GenOrder, true, true>(lds, g, S, E); }
    AFTER(8);
    STAMP(19);
    if (IN(9)) { const int fill_k = 9; FILL_BODY(true); }
    STAMP(20);
    if (IN(9)) {
for (int m = gw; m < NVALID; m += NGW) {
    const float rs = 1.0f / sqrtf(RSQ3[m] * (1.f / DM) + NORM_EPS);
    f32x4* yr = (f32x4*)(out + O_Y + (size_t)m * DM) + lane;
#pragma unroll
    for (int j = 0; j < 4; ++j) yr[64 * j] = yr[64 * j] * rs;
}
        }
    STAMP(21);
    if (PROBE_MULT > 0 && bid == 0 && tid == 0) { const unsigned long long a_ = ((unsigned long long)MISC[33 + 2 * PROBE_A] << 32) | MISC[32 + 2 * PROBE_A], b_ = ((unsigned long long)MISC[33 + 2 * PROBE_B] << 32) | MISC[32 + 2 * PROBE_B];
        const unsigned long long t0_ = rt(), ext_ = (b_ - a_) * (unsigned long long)PROBE_MULT; while (rt() - t0_ < ext_) __builtin_amdgcn_s_sleep(32); }
#undef AFTER
#undef GBAR
#undef ORDER
#undef IN
#undef FILL_BODY
#undef FILL_FETCH
}

#ifndef MK_N_LAUNCHES
#define MK_N_LAUNCHES 1
#endif
extern "C" void kernel_launch(void* const* d_in, const int* in_sizes, int n_in, void* d_out, int out_size, void* d_ws, size_t ws_size, hipStream_t stream) {
    static int grid = 0;
    if (grid == 0) {
        if (n_in != 16 || (size_t)out_size != O_END || ws_size < WS_END) { fprintf(stderr, "kernel_launch: unexpected shapes (n_in %d out %d ws %zu); nothing launched\n", n_in, out_size, ws_size); grid = -1; return; }
        int dev = 0, cus = 0, per_cu = 0;
        if (hipGetDevice(&dev) != hipSuccess || hipDeviceGetAttribute(&cus, hipDeviceAttributeMultiprocessorCount, dev) != hipSuccess) { grid = -1; return; }
        if (hipFuncSetAttribute((const void*)fwd, hipFuncAttributeMaxDynamicSharedMemorySize, LDS_BYTES) != hipSuccess) { fprintf(stderr, "kernel_launch: hipFuncSetAttribute failed\n"); grid = -1; return; }
        if (hipOccupancyMaxActiveBlocksPerMultiprocessor(&per_cu, (const void*)fwd, NWAVES * 64, LDS_BYTES) != hipSuccess || per_cu < 1) { fprintf(stderr, "kernel_launch: occupancy query says %d blocks per CU\n", per_cu); }
        (void)hipGetLastError();
        grid = cus;
    }
    if (grid < 0) return;
    (void)hipMemsetAsync((char*)d_ws + WS_CTL, 0, CTL_ZERO_BYTES, stream);
    Args a{};
    for (int i = 0; i < 16; ++i) a.in[i] = (const float*)d_in[i];
    a.out = (float*)d_out; a.ws = (unsigned char*)d_ws;
    if (MK_N_LAUNCHES == 1) { a.ph_lo = 0; a.ph_hi = NPHASE; hipLaunchKernelGGL(fwd, dim3(grid), dim3(NWAVES * 64), LDS_BYTES, stream, a); }
    else { for (int p = 0; p < NPHASE; ++p) { a.ph_lo = p; a.ph_hi = p + 1; hipLaunchKernelGGL(fwd, dim3(grid), dim3(NWAVES * 64), LDS_BYTES, stream, a); } }
}
```
